# Optimizing an MI355X kernel written in HIP

```python
import jax, jax.numpy as jnp
from jax import lax
import numpy as np

D_MODEL = 1024
BATCH = 16
SEQ = 2048
DEPTH = 2

GRID_W = 64
CTX_LEN = 256
N_EVEN = (DEPTH + 1) // 2
N_ODD = DEPTH // 2
EPS = 1e-6
N_MOD = 6

A_HEADS = 8
A_KV_HEADS = 2
A_GROUP = A_HEADS // A_KV_HEADS
A_HEAD_DIM = 64
ROPE_THETA = 10000.0
Q_BLOCK = 128

B_HEADS = 4
B_DK = 64
B_DV = 128
B_GATE_RANK = 16
B_GATE_TAU = 16.0
B_CHUNK = 64

AB_SIZES = (A_HEADS * A_HEAD_DIM, A_KV_HEADS * A_HEAD_DIM, A_KV_HEADS * A_HEAD_DIM,
            B_HEADS * B_DK, B_HEADS * B_DK, B_HEADS * B_DV, B_HEADS * B_DV,
            B_GATE_RANK, B_GATE_RANK)
AB_WIDTH = sum(AB_SIZES)
AB_OUT = A_HEADS * A_HEAD_DIM + B_HEADS * B_DV

C_HEADS = 16
C_HEAD_DIM = 64
C_WIDTH = C_HEADS * C_HEAD_DIM
NA_ROWS = 8
NA_COLS = 16

D_FF = 3584
N_EXPERTS = 8
TOP_K = 2

kernel_name = 'hybrid_dit_gqa_gla_natten_moe'


def _rmsnorm(x, g):
    x32 = x.astype(jnp.float32)
    y = x32 * lax.rsqrt(jnp.mean(x32 * x32, axis=-1, keepdims=True) + EPS)
    return (y * g.astype(jnp.float32)).astype(x.dtype)


def _modulate(h, shift, scale):
    return h * (1 + scale) + shift


def _adaln(cond, w_mod, b_mod):
    m = jax.nn.silu(cond) @ w_mod + b_mod
    return jnp.split(m[..., None, :], N_MOD, axis=-1)


def _swiglu(h, wg, wu, wd):
    return (jax.nn.silu(h @ wg) * (h @ wu)) @ wd


def _moe(h, w_router, wg, wu, wd):
    logits = (h @ w_router).astype(jnp.float32)
    top_v, top_i = lax.top_k(logits, TOP_K)
    gates = jax.nn.softmax(top_v, axis=-1)
    comb = jnp.sum(gates[..., None] * jax.nn.one_hot(top_i, N_EXPERTS, dtype=jnp.float32), axis=-2).astype(h.dtype)
    out = jnp.zeros_like(h)
    for e in range(N_EXPERTS):
        out = out + comb[..., e:e + 1] * _swiglu(h, wg[e], wu[e], wd[e])
    return out


def _rope_2d(seq_len):
    t = jnp.arange(seq_len, dtype=jnp.int32)
    row = (t // GRID_W).astype(jnp.float32)
    col = (t % GRID_W).astype(jnp.float32)
    n_axis = A_HEAD_DIM // 4
    inv = jnp.power(ROPE_THETA, -jnp.arange(n_axis, dtype=jnp.float32) / n_axis)
    ang = jnp.concatenate([row[:, None] * inv, col[:, None] * inv], axis=-1)
    return jnp.cos(ang), jnp.sin(ang)


def _apply_rope(x, cos, sin):
    shp = (1, x.shape[1]) + (1,) * (x.ndim - 3) + (cos.shape[-1],)
    cos = cos.reshape(shp).astype(x.dtype)
    sin = sin.reshape(shp).astype(x.dtype)
    xp = x.reshape(x.shape[:-1] + (-1, 2))
    x0, x1 = xp[..., 0], xp[..., 1]
    return jnp.stack([x0 * cos - x1 * sin, x0 * sin + x1 * cos], axis=-1).reshape(x.shape)


def _sdpa(q, k, v):
    s = jnp.einsum('bqkgd,bskd->bkgqs', q, k).astype(jnp.float32)
    p = jax.nn.softmax(s, axis=-1).astype(v.dtype)
    return jnp.einsum('bkgqs,bskd->bqkgd', p, v)


def _blocked_sdpa(q, k, v):
    bsz, seq_len = q.shape[:2]
    nb = seq_len // Q_BLOCK
    qb = jnp.moveaxis(q.reshape((bsz, nb, Q_BLOCK) + q.shape[2:]), 1, 0)
    ob = lax.map(lambda qi: _sdpa(qi, k, v), qb)
    return jnp.moveaxis(ob, 0, 1).reshape(q.shape)


def _log_decay(z, w2, b):
    bsz, tot, _ = z.shape
    la = jax.nn.log_sigmoid((z @ w2 + b).astype(jnp.float32)) / B_GATE_TAU
    return la.reshape(bsz, tot, B_HEADS, B_DK)


def _gla_chunked(q, k, v, log_a):
    bsz, tot, nh, dk = q.shape
    dv = v.shape[-1]
    n = tot // B_CHUNK

    def chunks(a):
        return a.astype(jnp.float32).reshape(bsz, n, B_CHUNK, nh, a.shape[-1]).transpose(0, 3, 1, 2, 4)

    qc, kc, vc = chunks(q), chunks(k), chunks(v)
    bcum = jnp.cumsum(chunks(log_a), axis=3)
    b_last = bcum[:, :, :, -1:, :]
    q_dec = qc * jnp.exp(bcum)
    k_intra = kc * jnp.exp(-bcum)
    k_state = kc * jnp.exp(b_last - bcum)
    lower = jnp.tril(jnp.ones((B_CHUNK, B_CHUNK), dtype=bool))
    att = jnp.where(lower, jnp.einsum('bhncd,bhnsd->bhncs', q_dec, k_intra), 0.0)
    o_intra = jnp.einsum('bhncs,bhnsv->bhncv', att, vc)
    d_state = jnp.einsum('bhncd,bhncv->bhndv', k_state, vc)
    chunk_decay = jnp.exp(b_last[:, :, :, 0, :])

    def step(state, inp):
        dec, ds = inp
        return dec[..., None] * state + ds, state

    s0 = jnp.zeros((bsz, nh, dk, dv), jnp.float32)
    _, s_prev = lax.scan(step, s0, (jnp.moveaxis(chunk_decay, 2, 0), jnp.moveaxis(d_state, 2, 0)))
    o_inter = jnp.einsum('bhncd,nbhdv->bhncv', q_dec, s_prev)
    o = (o_intra + o_inter).transpose(0, 2, 3, 1, 4).reshape(bsz, tot, nh, dv)
    return o.astype(v.dtype)


def _mixer_ab(h_lat, h_ctx, w_in, g_q, g_k, w_a2_f, b_a_f, w_a2_b, b_a_b, g_gla, w_out, need_ctx):
    bsz, seq_len, _ = h_lat.shape
    n_ctx = h_ctx.shape[1]
    tot = n_ctx + seq_len
    proj = jnp.concatenate([h_ctx, h_lat], axis=1) @ w_in
    q_a, k_a, v_a, q_b, k_b, v_b, r_b, z_f, z_b = jnp.split(proj, np.cumsum(AB_SIZES)[:-1].tolist(), axis=-1)

    q_a = _rmsnorm(q_a.reshape(bsz, tot, A_KV_HEADS, A_GROUP, A_HEAD_DIM), g_q) * (A_HEAD_DIM ** -0.5)
    k_a = _rmsnorm(k_a.reshape(bsz, tot, A_KV_HEADS, A_HEAD_DIM), g_k)
    v_a = v_a.reshape(bsz, tot, A_KV_HEADS, A_HEAD_DIM)
    cos, sin = _rope_2d(seq_len)
    q_lat = _apply_rope(q_a[:, n_ctx:], cos, sin)
    k_all = jnp.concatenate([k_a[:, :n_ctx], _apply_rope(k_a[:, n_ctx:], cos, sin)], axis=1)
    o_a_lat = _blocked_sdpa(q_lat, k_all, v_a).reshape(bsz, seq_len, A_HEADS * A_HEAD_DIM)

    q_b = q_b.reshape(bsz, tot, B_HEADS, B_DK) * (B_DK ** -0.5)
    k_b = k_b.reshape(bsz, tot, B_HEADS, B_DK)
    v_b = v_b.reshape(bsz, tot, B_HEADS, B_DV)
    la_f = _log_decay(z_f, w_a2_f, b_a_f)
    la_b = _log_decay(z_b, w_a2_b, b_a_b)

    def rev(a):
        return jnp.concatenate([a[:, :n_ctx][:, ::-1], a[:, n_ctx:][:, ::-1]], axis=1)

    o_f = _gla_chunked(q_b, k_b, v_b, la_f)
    o_r = rev(_gla_chunked(rev(q_b), rev(k_b), rev(v_b), rev(la_b)))
    o_b = _rmsnorm(o_f + o_r, g_gla).reshape(bsz, tot, B_HEADS * B_DV) * jax.nn.silu(r_b)

    y_lat = jnp.concatenate([o_a_lat, o_b[:, n_ctx:]], axis=-1) @ w_out
    if not need_ctx:
        return y_lat, None
    o_a_ctx = _sdpa(q_a[:, :n_ctx], k_a[:, :n_ctx], v_a[:, :n_ctx]).reshape(bsz, n_ctx, A_HEADS * A_HEAD_DIM)
    y_ctx = jnp.concatenate([o_a_ctx, o_b[:, :n_ctx]], axis=-1) @ w_out
    return y_lat, y_ctx


def _mixer_c(h_lat, h_ctx, w_in, rpb, w_out, need_ctx):
    bsz, seq_len, _ = h_lat.shape
    n_ctx = h_ctx.shape[1]
    rows = seq_len // GRID_W
    kr = min(NA_ROWS, rows)
    kc = NA_COLS
    scale = C_HEAD_DIM ** -0.5
    q, k, v = jnp.split(h_lat @ w_in, 3, axis=-1)
    grid = (bsz, rows, GRID_W, C_HEADS, C_HEAD_DIM)
    q = q.reshape(grid) * scale
    k = k.reshape(grid)
    v = v.reshape(grid)
    k_ctx, v_ctx = jnp.split(h_ctx @ w_in[:, C_WIDTH:], 2, axis=-1)
    k_ctx = k_ctx.reshape(bsz, n_ctx, C_HEADS, C_HEAD_DIM)
    v_ctx = v_ctx.reshape(bsz, n_ctx, C_HEADS, C_HEAD_DIM)

    cols = jnp.arange(GRID_W, dtype=jnp.int32)
    col_start = jnp.clip(cols - kc // 2, 0, GRID_W - kc)
    in_win = (cols[None, :] >= col_start[:, None]) & (cols[None, :] < col_start[:, None] + kc)
    col_idx = jnp.clip(cols[None, :] - cols[:, None] + NA_COLS - 1, 0, 2 * NA_COLS - 2)
    rpb_cols = rpb.astype(jnp.float32)[:, :, col_idx]

    def row_block(r):
        rs = jnp.clip(r - kr // 2, 0, rows - kr)
        dr_idx = rs + jnp.arange(kr, dtype=jnp.int32) - r + NA_ROWS - 1
        bias = jnp.where(in_win[None, None], rpb_cols[:, dr_idx], -jnp.inf)
        bias = bias.transpose(0, 2, 1, 3)
        q_r = lax.dynamic_index_in_dim(q, r, axis=1, keepdims=False)
        k_blk = lax.dynamic_slice_in_dim(k, rs, kr, axis=1)
        v_blk = lax.dynamic_slice_in_dim(v, rs, kr, axis=1)
        s_loc = jnp.einsum('bqhd,bikhd->bhqik', q_r, k_blk).astype(jnp.float32) + bias
        s_ctx = jnp.einsum('bqhd,bshd->bhqs', q_r, k_ctx).astype(jnp.float32)
        s = jnp.concatenate([s_loc.reshape(bsz, C_HEADS, GRID_W, kr * GRID_W), s_ctx], axis=-1)
        p = jax.nn.softmax(s, axis=-1).astype(v.dtype)
        p_loc = p[..., :kr * GRID_W].reshape(bsz, C_HEADS, GRID_W, kr, GRID_W)
        p_ctx = p[..., kr * GRID_W:]
        return jnp.einsum('bhqik,bikhd->bqhd', p_loc, v_blk) + jnp.einsum('bhqs,bshd->bqhd', p_ctx, v_ctx)

    o = lax.map(row_block, jnp.arange(rows, dtype=jnp.int32))
    y_lat = jnp.moveaxis(o, 0, 1).reshape(bsz, seq_len, C_WIDTH) @ w_out
    if not need_ctx:
        return y_lat, None
    q_ctx = (h_ctx @ w_in[:, :C_WIDTH]).reshape(bsz, n_ctx, C_HEADS, 1, C_HEAD_DIM) * scale
    o_ctx = _sdpa(q_ctx, k_ctx, v_ctx).reshape(bsz, n_ctx, C_WIDTH)
    return y_lat, o_ctx @ w_out


def setup_inputs(seed: int = 0) -> dict:
    key = jax.random.key(seed)
    keys = iter(jax.random.split(key, 40))

    def nrm(shape, s):
        return jax.random.normal(next(keys), shape, jnp.float32) * s

    def gain(shape):
        return 1.0 + nrm(shape, 0.02)

    d = D_MODEL
    return {
        'x': nrm((BATCH, SEQ, d), 1.0),
        'c': nrm((BATCH, d), 1.0),
        'ctx': nrm((BATCH, CTX_LEN, d), 1.0),
        'c_ctx': nrm((d,), 1.0),
        'w_mod': nrm((DEPTH, d, N_MOD * d), 0.5 * d ** -0.5),
        'b_mod': nrm((DEPTH, N_MOD * d), 0.01),
        'g_norm1': gain((DEPTH, d)),
        'g_norm2': gain((DEPTH, d)),
        'w_in_ab': nrm((N_EVEN, d, AB_WIDTH), d ** -0.5),
        'g_q': gain((N_EVEN, A_HEAD_DIM)),
        'g_k': gain((N_EVEN, A_HEAD_DIM)),
        'w_a2_f': nrm((N_EVEN, B_GATE_RANK, B_HEADS * B_DK), B_GATE_RANK ** -0.5),
        'b_a_f': nrm((N_EVEN, B_HEADS * B_DK), 0.1),
        'w_a2_b': nrm((N_EVEN, B_GATE_RANK, B_HEADS * B_DK), B_GATE_RANK ** -0.5),
        'b_a_b': nrm((N_EVEN, B_HEADS * B_DK), 0.1),
        'g_gla': gain((N_EVEN, B_DV)),
        'w_out_ab': nrm((N_EVEN, AB_OUT, d), AB_OUT ** -0.5),
        'w_ff_gate': nrm((N_EVEN, d, D_FF), d ** -0.5),
        'w_ff_up': nrm((N_EVEN, d, D_FF), d ** -0.5),
        'w_ff_down': nrm((N_EVEN, D_FF, d), D_FF ** -0.5),
        'w_in_c': nrm((N_ODD, d, 3 * C_WIDTH), d ** -0.5),
        'rpb_c': nrm((N_ODD, C_HEADS, 2 * NA_ROWS - 1, 2 * NA_COLS - 1), 0.02),
        'w_out_c': nrm((N_ODD, C_WIDTH, d), C_WIDTH ** -0.5),
        'w_router': nrm((N_ODD, d, N_EXPERTS), d ** -0.5),
        'w_moe_gate': nrm((N_ODD, N_EXPERTS, d, D_FF), d ** -0.5),
        'w_moe_up': nrm((N_ODD, N_EXPERTS, d, D_FF), d ** -0.5),
        'w_moe_down': nrm((N_ODD, N_EXPERTS, D_FF, d), D_FF ** -0.5),
        'g_final': gain((d,)),
    }


def reference(x, c, ctx, c_ctx, w_mod, b_mod, g_norm1, g_norm2, w_in_ab, g_q, g_k, w_a2_f, b_a_f,
              w_a2_b, b_a_b, g_gla, w_out_ab, w_ff_gate, w_ff_up, w_ff_down, w_in_c, rpb_c, w_out_c,
              w_router, w_moe_gate, w_moe_up, w_moe_down, g_final):
    for i in range(DEPTH):
        j = i // 2
        need_ctx = i < DEPTH - 1
        sh1, sc1, gt1, sh2, sc2, gt2 = _adaln(c, w_mod[i], b_mod[i])
        cmod = _adaln(c_ctx, w_mod[i], b_mod[i])
        h_lat = _modulate(_rmsnorm(x, g_norm1[i]), sh1, sc1)
        h_ctx = _modulate(_rmsnorm(ctx, g_norm1[i]), cmod[0], cmod[1])
        if i % 2 == 0:
            y_lat, y_ctx = _mixer_ab(h_lat, h_ctx, w_in_ab[j], g_q[j], g_k[j], w_a2_f[j], b_a_f[j],
                                     w_a2_b[j], b_a_b[j], g_gla[j], w_out_ab[j], need_ctx)

            def ffn(h):
                return _swiglu(h, w_ff_gate[j], w_ff_up[j], w_ff_down[j])
        else:
            y_lat, y_ctx = _mixer_c(h_lat, h_ctx, w_in_c[j], rpb_c[j], w_out_c[j], need_ctx)

            def ffn(h):
                return _moe(h, w_router[j], w_moe_gate[j], w_moe_up[j], w_moe_down[j])
        x = x + gt1 * y_lat
        x = x + gt2 * ffn(_modulate(_rmsnorm(x, g_norm2[i]), sh2, sc2))
        if need_ctx:
            ctx = ctx + cmod[2] * y_ctx
            ctx = ctx + cmod[5] * ffn(_modulate(_rmsnorm(ctx, g_norm2[i]), cmod[3], cmod[4]))
    return _rmsnorm(x, g_final)
```

```cpp
#include <hip/hip_runtime.h>
#include <cstdio>
#include <cstdint>

#ifndef MK_ONE_LAUNCH
#define MK_ONE_LAUNCH 1
#endif

__device__ __forceinline__ int lane_id() { int l; asm volatile("v_mbcnt_lo_u32_b32 %0, -1, 0\n\tv_mbcnt_hi_u32_b32 %0, -1, %0" : "=v"(l)); return l; }
namespace pg8 {
#define PG8_LAS __attribute__((address_space(3)))
typedef unsigned short bf16_t;
typedef short bf16x8 __attribute__((ext_vector_type(8)));
typedef float f32x4 __attribute__((ext_vector_type(4)));
typedef unsigned u32x4 __attribute__((ext_vector_type(4)));
constexpr int BM = 256, BK = 64, HALF = 128, HTB = HALF * BK * 2, STAGE_BYTES = 8 * HTB, NXCD = 8, WGM = 8;

__host__ __device__ __forceinline__ int lds_byte(int r, int c) { const int st = (r >> 4) * 2 + (c >> 5), rr = r & 15, cc = c & 31, ob = rr * 64 + cc * 2; return st * 1024 + (ob ^ (((ob >> 9) & 1) << 5)); }
__host__ __device__ __forceinline__ void stage_rc(int b, int& R, int& C) { const int st = b / 1024, sb = b % 1024, swz = sb ^ (((sb >> 9) & 1) << 5); R = (st >> 1) * 16 + swz / 64; C = (st & 1) * 32 + (swz % 64) / 2; }
__host__ __device__ __forceinline__ int perm32(int rho) { const int n = rho >> 4, i = rho & 15; return 8 * (i >> 2) + 4 * n + (i & 3); }

struct Unit { int pm, pn, pc, po, kb; };
struct Gemm { const bf16_t* A; const bf16_t* Bt; int K, ldb; };

struct Deal {
    int nM, nN, nwg, G, c;
    __device__ __forceinline__ void init(int nM_, int nN_, int G_, int c_) { nM = nM_; nN = nN_; nwg = nM_ * nN_; G = G_; c = c_; }
    __device__ __forceinline__ bool get(int i, int& lm, int& j) const {
        const long L = (long)i * G + c; if (L >= nwg) return false;
        int wgid = (int)L; { const int q = nwg / NXCD, r = nwg % NXCD, xcd = wgid % NXCD, off = wgid / NXCD; wgid = (xcd < r ? xcd * (q + 1) : r * (q + 1) + (xcd - r) * q) + off; }
        const int nig = WGM * nN, gid = wgid / nig, fm = gid * WGM, gsz = (nM - fm) < WGM ? (nM - fm) : WGM;
        lm = fm + ((wgid % nig) % gsz); j = (wgid % nig) / gsz; return true;
    }
};

__device__ __forceinline__ unsigned cvt_pk_bf16(float lo, float hi) { unsigned r; asm volatile("v_cvt_pk_bf16_f32 %0, %1, %2" : "=v"(r) : "v"(lo), "v"(hi)); return r; }

template <class Epi, class Sched, bool ALIGN_EPI>
__device__ __forceinline__ void gemm_phase(PG8_LAS unsigned char* lds, const int wid, const Gemm g, const Sched& S, const Epi& E) {
    const int lane = lane_id(), tid = wid * 64 + lane, wr = wid >> 2, wc = wid & 3, fr = lane & 15, fq = lane >> 4;
    const int K = g.K, nt = K / BK, ldb = g.ldb;
    unsigned voffB[2];
#pragma unroll
    for (int i = 0; i < 2; ++i) { int R, C; stage_rc(tid * 16 + i * 8192, R, C); const int Rb = (R & ~31) + perm32(R & 31);
        voffB[i] = (unsigned)(Rb * ldb + C) * 2u; }
    const size_t kstep = (size_t)(BK * 2);
    const size_t hstep = (size_t)HALF * ldb * 2;
    const size_t tstep = 2 * hstep;
    const unsigned ldsw = (unsigned)wid * 1024u;
    const int aoff = lds_byte(wr * 64 + fr, fq * 8), boff = lds_byte(wc * 32 + fr, fq * 8);
#define PG8_SA(b, h) (((b) * 2 + (h)) * HTB)
#define PG8_SB(b, h) ((4 + (b) * 2 + (h)) * HTB)
#define PG8_STAGE(bufoff, gbase, voff) do { _Pragma("unroll") for (int _i = 0; _i < 2; ++_i) \
        __builtin_amdgcn_global_load_lds((const unsigned*)((const char*)(gbase) + (voff)[_i]), (PG8_LAS unsigned*)(lds + (bufoff) + ldsw + _i * 8192), 16, 0, 0); } while (0)
#define PG8_LDA(dst, b, h) do { _Pragma("unroll") for (int m = 0; m < 4; ++m) _Pragma("unroll") for (int k = 0; k < 2; ++k) dst[m][k] = *(const PG8_LAS bf16x8*)(lds + PG8_SA(b, h) + aoff + m * 2048 + k * 1024); } while (0)
#define PG8_LDB(dst, b, h) do { _Pragma("unroll") for (int n = 0; n < 2; ++n) _Pragma("unroll") for (int k = 0; k < 2; ++k) dst[n][k] = *(const PG8_LAS bf16x8*)(lds + PG8_SB(b, h) + boff + n * 2048 + k * 1024); } while (0)
#define PG8_MMA(ai, bj, At, Bt) do { __builtin_amdgcn_s_setprio(1); _Pragma("unroll") for (int m = 0; m < 4; ++m) _Pragma("unroll") for (int n = 0; n < 2; ++n) _Pragma("unroll") for (int k = 0; k < 2; ++k) \
        acc[ai][bj][m][n] = __builtin_amdgcn_mfma_f32_16x16x32_bf16(Bt[n][k], At[m][k], acc[ai][bj][m][n], 0, 0, 0); __builtin_amdgcn_s_setprio(0); } while (0)
#define PG8_WAIT_V(n) asm volatile("s_waitcnt vmcnt(" #n ")" ::: "memory")
#define PG8_WAIT_L(n) asm volatile("s_waitcnt lgkmcnt(" #n ")" ::: "memory")
#define PG8_BAR __builtin_amdgcn_s_barrier()
#define PG8_SCHED __builtin_amdgcn_sched_barrier(0)
#define PG8_AOFF(dst, u) do { const int t_ = wid * 64 + lane_id(); _Pragma("unroll") for (int _i = 0; _i < 2; ++_i) { int R_, C_; stage_rc(t_ * 16 + _i * 8192, R_, C_);     \
        _Pragma("unroll") for (int _h = 0; _h < 2; ++_h) dst[_h][_i] = S.arow(u, _h * HALF + R_) + (unsigned)C_ * 2u; } } while (0)
    Unit cur, nxt; int ui = 0;
    if (!S.next(0, cur)) return;
    f32x4 acc[2][2][4][2];
#pragma unroll
    for (int a = 0; a < 2; ++a)
#pragma unroll
        for (int b = 0; b < 2; ++b)
#pragma unroll
            for (int m = 0; m < 4; ++m)
#pragma unroll
                for (int n = 0; n < 2; ++n) acc[a][b][m][n] = (f32x4){0.f, 0.f, 0.f, 0.f};
    bf16x8 At[4][2], B0[2][2], B1[2][2];
    const char* const Ab = (const char*)g.A; const char* cB = (const char*)g.Bt + (size_t)cur.pn * tstep + cur.kb;
    unsigned vAc[2][2], vAn[2][2];
    PG8_AOFF(vAc, cur);
    PG8_STAGE(PG8_SB(0, 0), cB, voffB); PG8_STAGE(PG8_SB(0, 1), cB + hstep, voffB); PG8_STAGE(PG8_SA(0, 0), Ab, vAc[0]); PG8_STAGE(PG8_SA(0, 1), Ab, vAc[1]);
    if (wr == 1) PG8_BAR;
    PG8_WAIT_V(2); PG8_BAR;
    PG8_STAGE(PG8_SB(1, 0), cB + kstep, voffB); PG8_STAGE(PG8_SA(1, 0), Ab + kstep, vAc[0]); PG8_STAGE(PG8_SB(1, 1), cB + hstep + kstep, voffB);
    PG8_WAIT_V(6); PG8_BAR;
    for (;;) {
        const bool has_next = S.next(ui + 1, nxt);
        const char* nB = has_next ? (const char*)g.Bt + (size_t)nxt.pn * tstep + nxt.kb : cB;
        if (has_next) { PG8_AOFF(vAn, nxt); } else {
#pragma unroll
            for (int h = 0; h < 2; ++h)
#pragma unroll
                for (int i = 0; i < 2; ++i) vAn[h][i] = vAc[h][i]; }
        for (int t = 0; t < nt; t += 2) {
            const bool last = (t == nt - 2);
            const char* a1 = Ab + (size_t)(t + 1) * kstep;
            const char* a2 = last ? Ab : Ab + (size_t)(t + 2) * kstep; const char* b2 = last ? nB : cB + (size_t)(t + 2) * kstep;
            const char* a3 = a2 + kstep; const char* b3 = b2 + kstep;
            unsigned va2[2][2];
#pragma unroll
            for (int h = 0; h < 2; ++h)
#pragma unroll
                for (int i = 0; i < 2; ++i) va2[h][i] = last ? vAn[h][i] : vAc[h][i];
            PG8_LDB(B0, 0, 0); PG8_LDB(B1, 0, 1); PG8_SCHED; PG8_LDA(At, 0, 0); PG8_STAGE(PG8_SA(1, 1), a1, vAc[1]);
            PG8_WAIT_V(8); PG8_WAIT_L(0); PG8_BAR; PG8_MMA(0, 0, At, B0); PG8_MMA(0, 1, At, B1); PG8_BAR; PG8_SCHED;
            PG8_LDA(At, 0, 1); PG8_STAGE(PG8_SB(0, 0), b2, voffB); PG8_STAGE(PG8_SB(0, 1), b2 + hstep, voffB); PG8_STAGE(PG8_SA(0, 0), a2, va2[0]);
            PG8_WAIT_V(8); PG8_WAIT_L(0); PG8_BAR; PG8_MMA(1, 0, At, B0); PG8_MMA(1, 1, At, B1); PG8_BAR; PG8_SCHED;
            PG8_LDB(B0, 1, 0); PG8_LDB(B1, 1, 1); PG8_SCHED; PG8_LDA(At, 1, 0); PG8_STAGE(PG8_SA(0, 1), a2, va2[1]);
            PG8_WAIT_V(8); PG8_WAIT_L(0); PG8_BAR; PG8_MMA(0, 0, At, B0); PG8_MMA(0, 1, At, B1); PG8_BAR; PG8_SCHED;
            PG8_LDA(At, 1, 1); PG8_STAGE(PG8_SB(1, 0), b3, voffB); PG8_STAGE(PG8_SB(1, 1), b3 + hstep, voffB); PG8_STAGE(PG8_SA(1, 0), a3, va2[0]);
            PG8_WAIT_V(8); PG8_WAIT_L(0); PG8_BAR; PG8_MMA(1, 0, At, B0); PG8_MMA(1, 1, At, B1); PG8_BAR; PG8_SCHED;
        }
        if constexpr (ALIGN_EPI) { if (wr == 0) PG8_BAR; }
        E(acc, cur, wr, wc);
        if (!has_next) break;
#pragma unroll
        for (int a = 0; a < 2; ++a)
#pragma unroll
            for (int b = 0; b < 2; ++b)
#pragma unroll
                for (int m = 0; m < 4; ++m)
#pragma unroll
                    for (int n = 0; n < 2; ++n) acc[a][b][m][n] = (f32x4){0.f, 0.f, 0.f, 0.f};
        cur = nxt; cB = nB; ++ui;
#pragma unroll
        for (int h = 0; h < 2; ++h)
#pragma unroll
            for (int i = 0; i < 2; ++i) vAc[h][i] = vAn[h][i];
        if constexpr (ALIGN_EPI) { if (wr == 1) PG8_BAR; }
    }
    PG8_WAIT_V(0);
    if constexpr (!ALIGN_EPI) { if (wr == 0) PG8_BAR; }
    PG8_BAR;
#undef PG8_SA
#undef PG8_SB
#undef PG8_STAGE
#undef PG8_LDA
#undef PG8_LDB
#undef PG8_MMA
#undef PG8_WAIT_V
#undef PG8_WAIT_L
#undef PG8_BAR
#undef PG8_SCHED
#undef PG8_AOFF
}
}

#include <hip/hip_bf16.h>
#include <cmath>
namespace attn_body {
using bf16=__hip_bfloat16;
using bf16x8=__attribute__((ext_vector_type(8)))short;
using s16x4=__attribute__((ext_vector_type(4)))short;
using f32x16=__attribute__((ext_vector_type(16)))float;
using u32x4=__attribute__((ext_vector_type(4)))unsigned;
constexpr int D=64;
constexpr int NW=8,QBLK=32,QB=QBLK*NW,KVBLK=64;
constexpr int ATTN_UNIT_ROWS=QB;
__device__ __forceinline__ int crow(int r,int hi){return (r&3)+8*(r>>2)+4*hi;}
#define SBAR() __builtin_amdgcn_sched_barrier(0)
__device__ __forceinline__ void cmask(f32x16&p0,f32x16&p1,int jb,int qrel,int hi){
  const float NEG=-INFINITY; int kb=64*jb+4*hi;
  #pragma unroll
  for(int r=0;r<16;++r){int kv=kb+(r&3)+8*(r>>2); if(kv>qrel)p0[r]=NEG; if(kv+32>qrel)p1[r]=NEG;}
}

constexpr int NSLOT=3, SLOTB=8192;
constexpr int LDS_K=0, LDS_V=NSLOT*SLOTB, LDS_WS=2*NSLOT*SLOTB, LDS_OST=LDS_WS+NW*64*4, LDS_BYTES=LDS_OST+NW*4096;
constexpr int TBL_OFF=LDS_BYTES;
constexpr int NAT_Z=0, NAT_NI=64, NAT_TI=128, NAT_TIW=120, NAT_TE=NAT_TI+15*NAT_TIW, NAT_TEP=80, NAT_TES=8*NAT_TEP, NAT_N=NAT_TE+15*NAT_TES;
__device__ __forceinline__ void na_bias_tables(char*shm,const float*rpbh,int tid){
  __attribute__((address_space(3))) float*tw=(__attribute__((address_space(3))) float*)((__attribute__((address_space(3))) char*)shm+TBL_OFF);
  const float NINF=-__builtin_inff(), L2E=1.4426950408889634f;
  for(int i=tid;i<NAT_N;i+=512){ float v;
    if(i<NAT_NI)v=0.f; else if(i<NAT_TI)v=NINF;
    else if(i<NAT_TE){ const int j=i-NAT_TI, dr=j/NAT_TIW, idx=j-dr*NAT_TIW-44; v=(idx>=7&&idx<=22)?rpbh[dr*31+idx]*L2E:NINF; }
    else { const int j=i-NAT_TE, dr=j/NAT_TES, q=j-dr*NAT_TES, p=q/NAT_TEP, o=q-p*NAT_TEP;
      if(o<16){ const int idx=o-p+15; v=rpbh[dr*31+idx]*L2E; }
      else if(o<64)v=NINF;
      else { const int kc=o-16, qc=56+p, idx=kc-qc+15; v=(p>0&&idx>=0&&idx<=30)?rpbh[dr*31+idx]*L2E:NINF; } }
    tw[i]=v; }
}
__device__ __forceinline__ float mask1(float x,int m32,int idx){ const unsigned sel=(unsigned)__builtin_amdgcn_sbfe(m32,idx,1); return __uint_as_float((__float_as_uint(x)&sel)|(~sel&0xff800000u)); }
constexpr float C2=0.125f*1.4426950408889634f;
__device__ __forceinline__ void glds16(const void*gsrc,unsigned lds_dst){unsigned keep;
  asm volatile("s_mov_b32 %0, m0\n\ts_mov_b32 m0, %2\n\ts_nop 0\n\tglobal_load_lds_dwordx4 %1, off\n\ts_mov_b32 m0, %0":"=&s"(keep):"v"(gsrc),"s"(lds_dst):"memory");}
__device__ __forceinline__ float max3f(float a,float b,float c){float r;asm("v_max3_f32 %0, %1, %2, %3":"=v"(r):"v"(a),"v"(b),"v"(c));return r;}
__device__ __forceinline__ float max2f(float a,float b){float r;asm("v_max_f32_e32 %0, %1, %2":"=v"(r):"v"(a),"v"(b));return r;}
__device__ __forceinline__ float fadd_s(float a,float b){float r;asm("v_add_f32_e32 %0, %1, %2":"=v"(r):"v"(a),"v"(b));return r;}
__device__ __forceinline__ float fsub_s(float a,float b){float r;asm("v_sub_f32_e32 %0, %1, %2":"=v"(r):"v"(a),"v"(b));return r;}
typedef float f32x2_t __attribute__((ext_vector_type(2))); typedef __bf16 bf16x2_t __attribute__((ext_vector_type(2)));
__device__ __forceinline__ unsigned cvtpk_s(float lo,float hi){f32x2_t v={lo,hi};bf16x2_t b=__builtin_convertvector(v,bf16x2_t);return __builtin_bit_cast(unsigned,b);}
#define WAIT_BAR(N) asm volatile("s_waitcnt vmcnt(" #N ") lgkmcnt(0)\n\ts_barrier":::"memory")

__device__ __forceinline__ void qkt(f32x16&p0,f32x16&p1,const char*Kslot,const bf16x8*qr,const f32x16&negm,int r32,int hi){
  const char*kb=Kslot+hi*1024+r32*16;
  #pragma unroll
  for(int d0=0;d0<4;++d0){
    const bf16x8 b0=*reinterpret_cast<const bf16x8*>(kb+d0*2048);
    const bf16x8 b1=*reinterpret_cast<const bf16x8*>(kb+d0*2048+512);
    if(d0==0){p0=__builtin_amdgcn_mfma_f32_32x32x16_bf16(b0,qr[0],negm,0,0,0);p1=__builtin_amdgcn_mfma_f32_32x32x16_bf16(b1,qr[0],negm,0,0,0);}
    else{p0=__builtin_amdgcn_mfma_f32_32x32x16_bf16(b0,qr[d0],p0,0,0,0);p1=__builtin_amdgcn_mfma_f32_32x32x16_bf16(b1,qr[d0],p1,0,0,0);}}
}
typedef __attribute__((address_space(3))) const char* lds_cptr;
typedef short v4i16_t __attribute__((ext_vector_type(4)));
__device__ __forceinline__ void kload8(bf16x8*kf,lds_cptr kp){
  kf[0]=*(const __attribute__((address_space(3))) bf16x8*)(kp);      kf[1]=*(const __attribute__((address_space(3))) bf16x8*)(kp+512);
  kf[2]=*(const __attribute__((address_space(3))) bf16x8*)(kp+2048); kf[3]=*(const __attribute__((address_space(3))) bf16x8*)(kp+2560);
  kf[4]=*(const __attribute__((address_space(3))) bf16x8*)(kp+4096); kf[5]=*(const __attribute__((address_space(3))) bf16x8*)(kp+4608);
  kf[6]=*(const __attribute__((address_space(3))) bf16x8*)(kp+6144); kf[7]=*(const __attribute__((address_space(3))) bf16x8*)(kp+6656);
}
__device__ __forceinline__ void kload2(bf16x8*kf,lds_cptr kp,int j){ kf[2*j]=*(const __attribute__((address_space(3))) bf16x8*)(kp+j*2048); kf[2*j+1]=*(const __attribute__((address_space(3))) bf16x8*)(kp+j*2048+512); }
__device__ __forceinline__ s16x4 vtr(lds_cptr p){ return __builtin_bit_cast(s16x4,__builtin_amdgcn_ds_read_tr16_b64_v4i16((__attribute__((address_space(3))) v4i16_t*)p)); }
__device__ __forceinline__ float rowmax(const f32x16&p0,const f32x16&p1){
  float a=max3f(p0[0],p0[1],p1[0]),b=max3f(p0[2],p0[3],p1[1]);a=max3f(a,p1[2],p1[3]);
  #pragma unroll
  for(int r=4;r<16;r+=4){a=max3f(a,p0[r],p0[r+1]);b=max3f(b,p0[r+2],p0[r+3]);a=max3f(a,p1[r],p1[r+1]);b=max3f(b,p1[r+2],p1[r+3]);}
  const float m=max2f(a,b);
  auto rr=__builtin_amdgcn_permlane32_swap(__float_as_uint(m),__float_as_uint(m),false,false);
  return max2f(__uint_as_float(rr[0]),__uint_as_float(rr[1]));
}
__device__ __forceinline__ void pv(f32x16*o,int vb,bf16x8 pa0,bf16x8 pa1,bf16x8 pa2,bf16x8 pa3){
  #pragma unroll
  for(int d0=0;d0<2;++d0){s16x4 lo[4],hi[4];
    #pragma unroll
    for(int ks=0;ks<4;++ks){
      asm volatile("ds_read_b64_tr_b16 %0,%1 offset:%c2":"=&v"(lo[ks]):"v"(vb),"i"(d0*4096+ks*1024):"memory");
      asm volatile("ds_read_b64_tr_b16 %0,%1 offset:%c2":"=&v"(hi[ks]):"v"(vb),"i"(d0*4096+ks*1024+512):"memory");}
    asm volatile("s_waitcnt lgkmcnt(0)":::"memory");SBAR();
    #define PK(k) (bf16x8){lo[k][0],lo[k][1],lo[k][2],lo[k][3],hi[k][0],hi[k][1],hi[k][2],hi[k][3]}
    o[d0]=__builtin_amdgcn_mfma_f32_32x32x16_bf16(pa0,PK(0),o[d0],0,0,0);
    o[d0]=__builtin_amdgcn_mfma_f32_32x32x16_bf16(pa1,PK(1),o[d0],0,0,0);
    o[d0]=__builtin_amdgcn_mfma_f32_32x32x16_bf16(pa2,PK(2),o[d0],0,0,0);
    o[d0]=__builtin_amdgcn_mfma_f32_32x32x16_bf16(pa3,PK(3),o[d0],0,0,0);
    #undef PK
  }
}

#ifndef ATTN_STORE16
#define ATTN_STORE16(p,v) (*(u32x4*)(p)=(v))
#endif
template<int THRL,int QP,int OP,bool NA> __device__ __forceinline__ void attn_unit(const bf16*Qu,const bf16*__restrict__ Kh,const bf16*__restrict__ Vh,bf16*Ou,const int NT,char*shm,const int klo,const int r0,const float*rpbh,const int wid){
  const int lane=lane_id(),tid=wid*64+lane,r32=lane&31,hi=lane>>5;
  const bf16*Qw=Qu+(long)(wid*QBLK)*QP;
  const unsigned lds0=(unsigned)(uintptr_t)shm;
  float*wsf=(float*)(shm+LDS_WS)+wid*64;
  const bf16*ksrc=Kh+(long)lane*QP+wid*8;
  const bf16*vsrc=Vh+(long)(16*(wid&3)+(lane>>2))*QP+(wid>>2)*32+(lane&3)*8;
  const unsigned kdst=lds0+LDS_K+wid*1024, vdst=lds0+LDS_V+wid*1024;
  #define TBLK(t) (NA?((t)<4?(t):(t)+klo):(t))
  #define DMA_K(t,slot) glds16(ksrc+(long)TBLK(t)*KVBLK*QP,(unsigned)__builtin_amdgcn_readfirstlane(kdst+(slot)))
  #define DMA_V(t,slot) glds16(vsrc+(long)TBLK(t)*KVBLK*QP,(unsigned)__builtin_amdgcn_readfirstlane(vdst+(slot)))
  const int vb0=(int)(lds0+LDS_V)+((lane>>4)&1)*32+(lane&3)*8+(4*hi+((lane&15)>>2))*64;
  const char*Kbase=shm+LDS_K; bf16x8 kf[8];
  const lds_cptr shm3=(lds_cptr)shm; const lds_cptr kp0=shm3+LDS_K+hi*1024+r32*16; const lds_cptr vp0=shm3+LDS_V+((lane>>4)&1)*32+(lane&3)*8+(4*hi+((lane&15)>>2))*64;
  DMA_K(0,0);DMA_V(0,0);DMA_K(1,SLOTB);
  bf16x8 qr[4];
  #pragma unroll
  for(int d0=0;d0<4;++d0)qr[d0]=*reinterpret_cast<const bf16x8*>(&Qw[(long)r32*QP+d0*16+hi*8]);
  float mhat=0.f,l_reg=0.f;f32x16 o[2];o[0]=f32x16{};o[1]=f32x16{};asm volatile("":"+v"(o[0]),"+v"(o[1]));f32x16 negm=f32x16{};asm volatile("":"+v"(negm));
  const int rq=r0+(wid>>1), rsq=min(max(rq-4,0),24), qcol=32*(wid&1)+r32, cs=min(max(qcol-8,0),48);
  typedef __attribute__((address_space(3))) const float* lds_fptr;
  const lds_fptr tblf=(lds_fptr)((__attribute__((address_space(3))) const char*)shm+TBL_OFF);
  const lds_fptr tbl_lane=tblf+(qcol<8?NAT_TE+qcol*NAT_TEP+4*hi:(qcol>56?NAT_TE+(qcol-56)*NAT_TEP+16+4*hi:NAT_TI+4*hi-qcol+15+44));
  const int tbl_pitch=(qcol<8||qcol>56)?NAT_TES:NAT_TIW;
  const lds_fptr zrow=tblf+NAT_Z+4*hi, nirow=tblf+NAT_NI+4*hi;
  #define CMASK(P0,P1,t) do{ if(NA){ const int krow_=klo+(t)-4; const bool loc_=(t)>=4, rel_=loc_&&krow_>=rsq&&krow_<rsq+8; \
      const lds_fptr tp_=rel_?tbl_lane+(krow_-rq+7)*tbl_pitch:(loc_?nirow:zrow); \
      _Pragma("unroll") for(int r=0;r<16;++r){ const int kr_=(r&3)+8*(r>>2); P0[r]+=tp_[kr_]; P1[r]+=tp_[kr_+32]; } } }while(0)
  bool resc=false;
  #define START(P0,P1) do{ const float rm=rowmax(P0,P1); resc=false; \
    { const float dl=rm; mhat=fadd_s(mhat,dl); \
      _Pragma("unroll") for(int r=0;r<16;++r){P0[r]=fsub_s(P0[r],dl);P1[r]=fsub_s(P1[r],dl);} \
      _Pragma("unroll") for(int r=0;r<16;++r)negm[r]=-mhat; asm volatile("":"+v"(negm)); } \
    _Pragma("unroll") for(int r=0;r<16;++r)P0[r]=__builtin_amdgcn_exp2f(P0[r]); }while(0)
  #define RESC() do{ if(resc){ asm volatile("s_waitcnt lgkmcnt(0)":::"memory"); \
      _Pragma("unroll") for(int d_=0;d_<2;++d_) _Pragma("unroll") for(int r=0;r<16;++r)o[d_][r]*=wsf[crow(r,hi)]; } }while(0)
  f32x16 pA0,pA1,pB0,pB1;
  int sl_prev=0,sl_cur=0,sl_next=SLOTB;
  #define ROT() do{sl_prev=sl_cur;sl_cur=sl_next;sl_next=(sl_next==(NSLOT-1)*SLOTB)?0:sl_next+SLOTB;}while(0)
  DMA_K(2,2*SLOTB);
  WAIT_BAR(3);
  qkt(pA0,pA1,Kbase,qr,negm,r32,hi);asm volatile("s_nop 15\n\ts_nop 7":"+v"(pA0),"+v"(pA1));
  START(pA0,pA1);
  _Pragma("unroll") for(int r=0;r<16;++r)pA1[r]=__builtin_amdgcn_exp2f(pA1[r]);
  WAIT_BAR(0);
  DMA_K(3,0);DMA_V(1,SLOTB);
  ROT();
  kload8(kf,kp0+sl_cur);
  WAIT_BAR(2);
  s16x4 vlo[8],vhi[8]; u32x4 pw0,pw1,pw2,pw3;
  #define PKW(P,B) cvtpk_s(P[B],P[B+1])
  #define PAF(k) __builtin_bit_cast(bf16x8,pw##k)
  #define VFR(i) (bf16x8){vlo[i][0],vlo[i][1],vlo[i][2],vlo[i][3],vhi[i][0],vhi[i][1],vhi[i][2],vhi[i][3]}
  #define PIN(x) asm volatile("":"+v"(x))
  #define MX3(a,b,c) __builtin_fmaxf(__builtin_fmaxf((a),(b)),(c))
  #define GAPA(MF,A0,A1,A2,A3,W0,W1,PW) do{ MF; sacc+=A0; sacc+=A1; sacc+=A2; sacc+=A3; PIN(sacc); W0; W1; PIN(PW); SBAR(); }while(0)
  #define EX(v) __builtin_amdgcn_exp2f(v)
  #define GAPB(MF,X,B) do{ MF; X[B]=EX(X[B]); X[B+1]=EX(X[B+1]); X[B+2]=EX(X[B+2]); X[B+3]=EX(X[B+3]); PIN(X); SBAR(); }while(0)
  #define VRD(i) do{ vlo[i]=vtr(vp_+(((i)>>2)*4096+((i)&3)*1024)); vhi[i]=vtr(vp_+(((i)>>2)*4096+((i)&3)*1024+512)); }while(0)
  #define KRD(G,j) do{ if(G){ kload2(kf,kp0+sl_next,j); SBAR(); } }while(0)
  #define STEP(C0,C1,P0,P1,t,GK,GV,GL) do{ SBAR(); \
    const lds_cptr vp_=vp0+sl_prev; \
    VRD(0); SBAR(); float sacc=(P0[0]+P0[1]); \
    GAPA(C0=__builtin_amdgcn_mfma_f32_32x32x16_bf16(kf[0],qr[0],negm,0,0,0), P0[2],P0[3],P0[4],P0[5],     pw0[0]=PKW(P0,0), pw0[1]=PKW(P0,2), pw0); \
    VRD(4); SBAR(); GAPA(C1=__builtin_amdgcn_mfma_f32_32x32x16_bf16(kf[1],qr[0],negm,0,0,0), P0[6],P0[7],P0[8],P0[9],     pw0[2]=PKW(P0,4), pw0[3]=PKW(P0,6), pw0); \
    VRD(1); SBAR(); GAPA(C0=__builtin_amdgcn_mfma_f32_32x32x16_bf16(kf[2],qr[1],C0,0,0,0),   P0[10],P0[11],P0[12],P0[13], pw1[0]=PKW(P0,8), pw1[1]=PKW(P0,10), pw1); \
    VRD(5); SBAR(); GAPA(C1=__builtin_amdgcn_mfma_f32_32x32x16_bf16(kf[3],qr[1],C1,0,0,0),   P0[14],P0[15],P1[0],P1[1],   pw1[2]=PKW(P0,12),pw1[3]=PKW(P0,14), pw1); \
    VRD(2); SBAR(); GAPA(C0=__builtin_amdgcn_mfma_f32_32x32x16_bf16(kf[4],qr[2],C0,0,0,0),   P1[2],P1[3],P1[4],P1[5],     pw2[0]=PKW(P1,0), pw2[1]=PKW(P1,2), pw2); \
    VRD(6); SBAR(); GAPA(C1=__builtin_amdgcn_mfma_f32_32x32x16_bf16(kf[5],qr[2],C1,0,0,0),   P1[6],P1[7],P1[8],P1[9],     pw2[2]=PKW(P1,4), pw2[3]=PKW(P1,6), pw2); \
    VRD(3); SBAR(); GAPA(C0=__builtin_amdgcn_mfma_f32_32x32x16_bf16(kf[6],qr[3],C0,0,0,0),   P1[10],P1[11],P1[12],P1[13], pw3[0]=PKW(P1,8), pw3[1]=PKW(P1,10), pw3); \
    VRD(7); SBAR(); GAPA(C1=__builtin_amdgcn_mfma_f32_32x32x16_bf16(kf[7],qr[3],C1,0,0,0),   P1[14],P1[15],0.f,0.f,       pw3[2]=PKW(P1,12),pw3[3]=PKW(P1,14), pw3); \
    l_reg+=sacc; \
    if(GK){DMA_K((t)+3,sl_cur);} if(GV){DMA_V((t)+1,sl_next);} \
    CMASK(C0,C1,t); \
    { float a=MX3(C0[0],C0[1],C1[0]),b=MX3(C0[2],C0[3],C1[1]); a=MX3(a,C1[2],C1[3]); \
      _Pragma("unroll") for(int r=4;r<16;r+=4){a=MX3(a,C0[r],C0[r+1]);b=MX3(b,C0[r+2],C0[r+3]);a=MX3(a,C1[r],C1[r+1]);b=MX3(b,C1[r+2],C1[r+3]);} \
      float rm=__builtin_fmaxf(a,b); { auto rr=__builtin_amdgcn_permlane32_swap(__float_as_uint(rm),__float_as_uint(rm),false,false); rm=__builtin_fmaxf(__uint_as_float(rr[0]),__uint_as_float(rr[1])); } \
      resc=false; \
      if(__builtin_expect(__any(rm>(float)THRL),0)){ const float dl=__builtin_fmaxf(rm,0.f); mhat+=dl; \
        _Pragma("unroll") for(int r=0;r<16;++r){C0[r]-=dl;C1[r]-=dl;} \
        _Pragma("unroll") for(int r=0;r<16;++r)negm[r]=-mhat; asm volatile("":"+v"(negm)); \
        const float f=__builtin_amdgcn_exp2f(-dl); l_reg*=f; if(hi==0)wsf[r32]=f; resc=true; } } \
    SBAR(); \
    GAPB(o[0]=__builtin_amdgcn_mfma_f32_32x32x16_bf16(PAF(0),VFR(0),o[0],0,0,0), C0,0); \
    GAPB(o[1]=__builtin_amdgcn_mfma_f32_32x32x16_bf16(PAF(0),VFR(4),o[1],0,0,0), C0,4); \
    KRD(GL,0); GAPB(o[0]=__builtin_amdgcn_mfma_f32_32x32x16_bf16(PAF(1),VFR(1),o[0],0,0,0), C0,8); \
    KRD(GL,1); GAPB(o[1]=__builtin_amdgcn_mfma_f32_32x32x16_bf16(PAF(1),VFR(5),o[1],0,0,0), C0,12); \
    KRD(GL,2); GAPB(o[0]=__builtin_amdgcn_mfma_f32_32x32x16_bf16(PAF(2),VFR(2),o[0],0,0,0), C1,0); \
    KRD(GL,3); GAPB(o[1]=__builtin_amdgcn_mfma_f32_32x32x16_bf16(PAF(2),VFR(6),o[1],0,0,0), C1,4); \
    GAPB(o[0]=__builtin_amdgcn_mfma_f32_32x32x16_bf16(PAF(3),VFR(3),o[0],0,0,0), C1,8); \
    GAPB(o[1]=__builtin_amdgcn_mfma_f32_32x32x16_bf16(PAF(3),VFR(7),o[1],0,0,0), C1,12); \
    }while(0)
  int t=1;
  for(;t+5<NT;t+=2){
    STEP(pB0,pB1,pA0,pA1,t,true,true,true);     WAIT_BAR(2); RESC(); ROT();
    STEP(pA0,pA1,pB0,pB1,t+1,true,true,true);   WAIT_BAR(2); RESC(); ROT();
  }
  #define ENDW(tt) do{ if((tt)+3<NT){WAIT_BAR(2);} else if((tt)+2<NT){WAIT_BAR(1);} else {WAIT_BAR(0);} }while(0)
  for(;t+1<NT;t+=2){
    STEP(pB0,pB1,pA0,pA1,t,(t+3<NT),(t+1<NT),(t+1<NT));       ENDW(t);   RESC(); ROT();
    STEP(pA0,pA1,pB0,pB1,t+1,(t+4<NT),(t+2<NT),(t+2<NT));     ENDW(t+1); RESC(); ROT();
  }
  STEP(pB0,pB1,pA0,pA1,NT-1,false,false,false); RESC();
  { float sacc=pB0[0]+pB0[1]; _Pragma("unroll") for(int r=2;r<16;++r)sacc+=pB0[r]; _Pragma("unroll") for(int r=0;r<16;++r)sacc+=pB1[r]; l_reg+=sacc;
    pw0=(u32x4){PKW(pB0,0),PKW(pB0,2),PKW(pB0,4),PKW(pB0,6)};pw1=(u32x4){PKW(pB0,8),PKW(pB0,10),PKW(pB0,12),PKW(pB0,14)};pw2=(u32x4){PKW(pB1,0),PKW(pB1,2),PKW(pB1,4),PKW(pB1,6)};pw3=(u32x4){PKW(pB1,8),PKW(pB1,10),PKW(pB1,12),PKW(pB1,14)};
    SBAR(); pv(o,vb0+sl_cur,PAF(0),PAF(1),PAF(2),PAF(3)); }
  #undef PKW
  #undef PAF
  #undef VFR
  #undef PIN
  #undef MX3
  #undef GAPA
  #undef GAPB
  #undef EX
  #undef VRD
  #undef KRD
  #undef STEP
  #undef ENDW
  {auto rr=__builtin_amdgcn_permlane32_swap(__float_as_uint(l_reg),__float_as_uint(l_reg),false,false);l_reg=__uint_as_float(rr[0])+__uint_as_float(rr[1]);}
  if(hi==0)wsf[32+r32]=l_reg;asm volatile("s_waitcnt lgkmcnt(0)":::"memory");
  float rli[16];
  #pragma unroll
  for(int r=0;r<16;++r)rli[r]=__builtin_amdgcn_rcpf(wsf[32+crow(r,hi)]);
  bf16*Ow=Ou+(long)(wid*QBLK)*OP;
  { bf16*stg=(bf16*)(shm+LDS_OST)+wid*2048;
    #pragma unroll
    for(int r=0;r<16;++r){const int orow=crow(r,hi);
      #pragma unroll
      for(int d0=0;d0<2;++d0)stg[orow*64+d0*32+r32]=__float2bfloat16(o[d0][r]*rli[r]);}
    asm volatile("s_waitcnt lgkmcnt(0)":::"memory");
    #pragma unroll
    for(int i=0;i<4;++i){const int row=i*8+(lane>>3),ch=lane&7; const u32x4 v=*(const u32x4*)(stg+row*64+ch*8); ATTN_STORE16(Ow+(long)row*OP+ch*8,v);} }
  asm volatile("s_waitcnt lgkmcnt(0)\n\ts_barrier":::"memory");
  #undef DMA_K
  #undef TBLK
  #undef DMA_V
  #undef CMASK
  #undef START
  #undef RESC
  #undef ROT
}
constexpr int ATTN_LDS_BYTES=LDS_BYTES;
#undef SBAR
#undef WAIT_BAR
}
constexpr int NWAVES = 8, NTHR = 512;
constexpr int DM = 1024, NB = 16, SEQ = 2048, NCTX = 256, TOT = SEQ + NCTX;
constexpr int MROWS = NB * TOT;
constexpr int NLAT = NB * SEQ;
constexpr int GRIDW = 64;
constexpr int ABW = 2336, ABP = 2560;
constexpr int DFF = 3584, NEXP = 8;
constexpr int QKVW = 3072;
constexpr float EPS = 1e-6f;
constexpr float LOG2E = 1.4426950408889634f;
constexpr float C2 = 0.125f * LOG2E;
constexpr int PA_Q = 0, PA_K = 512, PA_V = 640, PB_Q = 768, PB_K = 1024, PB_V = 1280, PB_R = 1792, PZ_F = 2304, PZ_B = 2320;
constexpr int MOE_CHUNK = 128, MOE_NCHUNK = 3, MOE_MAXT = 264;

constexpr size_t MiB = 1u << 20;
constexpr size_t WS_CTL = 0, CTL_ZERO_BYTES = 1 * MiB;
constexpr size_t WS_MOD = 1 * MiB;
constexpr size_t WS_RE = 2 * MiB;
constexpr size_t WS_RG = WS_RE + 256 * 1024;
constexpr size_t WS_SLOT = WS_RG + 256 * 1024;
constexpr size_t WS_ROWIDX = WS_SLOT + 256 * 1024;
constexpr size_t WS_CNT = WS_ROWIDX + 512 * 1024;
constexpr size_t WS_TB = WS_CNT + 16 * 1024;
constexpr size_t WS_CTXS = 4 * MiB;
constexpr size_t WS_WINAB = 20 * MiB, WS_WOUTAB = 25 * MiB, WS_WFF1 = 27 * MiB, WS_WFF2 = 41 * MiB, WS_WINC = 48 * MiB, WS_WOUTC = 54 * MiB, WS_WMOE1 = 56 * MiB, WS_WMOE2 = 168 * MiB;
constexpr size_t WS_A = 224 * MiB;
constexpr size_t WS_XL = WS_A, WS_XC = WS_A + 64 * MiB;
constexpr size_t WS_B = 296 * MiB;
constexpr size_t WS_PROJ0 = WS_B, WS_GLAF = WS_B + 180 * MiB, WS_GLAR = WS_B + 216 * MiB;
constexpr size_t WS_ACT = WS_B, WS_QKV = WS_B;
constexpr size_t WS_ACTC = WS_B;
constexpr size_t WS_YA = WS_B + 224 * MiB;
constexpr size_t WS_YB = WS_WMOE1;
constexpr size_t WS_PART = 4 * MiB;
constexpr size_t WS_PARTC = WS_B + 252 * MiB;
constexpr size_t WS_END = WS_PARTC + 48 * MiB;
static_assert(WS_YA + (size_t)32768 * 1024 * 2 <= WS_END && WS_ACTC + (size_t)MOE_CHUNK * 256 * 3584 * 2 <= WS_YA && WS_PART + 32 * MiB <= WS_WFF2 && MOE_CHUNK * 2 * 256 == 65536, "ws map");
constexpr int CW_TMO = 0, CW_BAR = 4096;

constexpr int RING_BYTES = 131072, LDSCTL_OFF = RING_BYTES, MISC_OFF = LDSCTL_OFF + 320, LDS_BYTES = 147456;

#define GAS __attribute__((address_space(1)))
#define LAS __attribute__((address_space(3)))
typedef unsigned short bf16;
typedef unsigned v4u __attribute__((ext_vector_type(4)));
typedef unsigned v2u __attribute__((ext_vector_type(2)));
typedef float f32x4 __attribute__((ext_vector_type(4)));
typedef float f32x2 __attribute__((ext_vector_type(2)));
typedef GAS unsigned gu32;
#define RLX_AGENT __ATOMIC_RELAXED, __HIP_MEMORY_SCOPE_AGENT
#define LDS_WAIT() asm volatile("s_waitcnt lgkmcnt(0)" ::: "memory")
#define LDS_BARRIER() asm volatile("s_waitcnt lgkmcnt(0)\n\ts_barrier" ::: "memory")
__device__ __forceinline__ unsigned f2bf(float f) { unsigned u = __builtin_bit_cast(unsigned, f); return (u + 0x7fffu + ((u >> 16) & 1u)) >> 16; }
__device__ __forceinline__ unsigned pk2(float lo, float hi) { return f2bf(lo) | (f2bf(hi) << 16); }
__device__ __forceinline__ float bf2f(unsigned short h) { return __builtin_bit_cast(float, (unsigned)h << 16); }
__device__ __forceinline__ float bflo(unsigned w) { return __builtin_bit_cast(float, w << 16); }
__device__ __forceinline__ float bfhi(unsigned w) { return __builtin_bit_cast(float, w & 0xffff0000u); }
__device__ __forceinline__ float fexp2(float x) { return __builtin_amdgcn_exp2f(x); }
__device__ __forceinline__ float frcp(float x) { return __builtin_amdgcn_rcpf(x); }
__device__ __forceinline__ float silu_f(float x) { return x * frcp(1.f + fexp2(-x * LOG2E)); }
__device__ __forceinline__ float wave_sum(float v) {
#pragma unroll
    for (int o = 1; o < 64; o <<= 1) v += __shfl_xor(v, o);
    return v;
}

#define XB_TMO      128
#define XB_XCNT(j)  (256  + 64 * (j))
#define XB_XSUB(j)  (1280 + 64 * (j))
#define XB_XGEN(j)  (2304 + 64 * (j))
#define XB_TOP      3328
#define XB_TOPGEN   3392
#define XCD_BAR_WORDS 3456
#define XB_SPIN_CAP (1u << 22)
__device__ __forceinline__ unsigned xb_ld(unsigned* p)              { return __hip_atomic_load(p, __ATOMIC_RELAXED, __HIP_MEMORY_SCOPE_AGENT); }
__device__ __forceinline__ unsigned xb_add(unsigned* p, unsigned v) { return __hip_atomic_fetch_add(p, v, __ATOMIC_RELAXED, __HIP_MEMORY_SCOPE_AGENT); }
__device__ __forceinline__ unsigned xb_xcc_id() { return (unsigned)__builtin_amdgcn_s_getreg((3 << 11) | 20) & 0xFu; }
#define XB_SPIN(cond, bar) do { unsigned _sp = 0; while (cond) { __builtin_amdgcn_s_sleep(1); \
    if ((++_sp & 255u) == 0u) { if (xb_ld(&(bar)[XB_TMO])) break; if (_sp > XB_SPIN_CAP) { atomicAdd(&(bar)[XB_TMO], 1u); break; } } } } while (0)
struct XcdBarrier { unsigned* bar; unsigned x; volatile LAS unsigned* st; };
__device__ __forceinline__ XcdBarrier xcd_barrier_post(unsigned* bar, volatile LAS unsigned* st) {
    XcdBarrier b; b.bar = bar; b.x = xb_xcc_id(); b.st = st;
    if (threadIdx.x == 0) (void)xb_add(&bar[XB_XCNT(b.x)], 1u);
    return b;
}
__device__ __forceinline__ void xcd_barrier_complete(unsigned* bar, unsigned x, unsigned& nloc, unsigned& nx) {
    const unsigned G = gridDim.x * gridDim.y * gridDim.z;
    unsigned sum, cnt, mine, sp = 0u;
    for (;;) {
        sum = 0u; cnt = 0u; mine = 0u;
#pragma unroll
        for (unsigned j = 0; j < 16; ++j) { const unsigned c = xb_ld(&bar[XB_XCNT(j)]); sum += c; cnt += (c > 0u) ? 1u : 0u; mine = (j == x) ? c : mine; }
        if (sum == G) break;
        __builtin_amdgcn_s_sleep(1);
        if ((++sp & 255u) == 0u) { if (xb_ld(&bar[XB_TMO])) break; if (sp > XB_SPIN_CAP) { atomicAdd(&bar[XB_TMO], 1u); break; } }
    }
    nloc = mine > 0u ? mine : 1u; nx = cnt > 0u ? cnt : 1u;
}
__device__ __forceinline__ void xcd_barrier(const XcdBarrier& b) {
    asm volatile("s_waitcnt vmcnt(0)" ::: "memory");
    __syncthreads();
    if (threadIdx.x == 0) {
        unsigned* bar = b.bar;
        __builtin_amdgcn_s_waitcnt(0);
        unsigned nloc = b.st[0], nx = b.st[1];
        if (nloc == 0u) { xcd_barrier_complete(bar, b.x, nloc, nx); b.st[0] = nloc; b.st[1] = nx; }
        const unsigned old = xb_add(&bar[XB_XSUB(b.x)], 1u);
        const unsigned gen = old / nloc;
        if (old + 1u == (gen + 1u) * nloc) {
            __builtin_amdgcn_fence(__ATOMIC_RELEASE, "agent");
            asm volatile("s_waitcnt vmcnt(0)" ::: "memory");
            const unsigned og = xb_add(&bar[XB_TOP], 1u);
            const unsigned tg = og / nx;
            if (og + 1u == (tg + 1u) * nx) xb_add(&bar[XB_TOPGEN], 1u);
            else XB_SPIN(xb_ld(&bar[XB_TOPGEN]) == tg, bar);
            __builtin_amdgcn_fence(__ATOMIC_ACQUIRE, "agent");
            xb_add(&bar[XB_XGEN(b.x)], 1u);
            asm volatile("s_waitcnt vmcnt(0)" ::: "memory");
        } else {
            XB_SPIN(xb_ld(&bar[XB_XGEN(b.x)]) == gen, bar);
            __builtin_amdgcn_fence(__ATOMIC_ACQUIRE, "agent");
            asm volatile("s_waitcnt vmcnt(0)" ::: "memory");
        }
    }
    __syncthreads();
}

struct Args { const float* in[28]; float* out; unsigned char* ws; int ph_lo, ph_hi; };
enum { I_X = 0, I_C, I_CTX, I_CCTX, I_WMOD, I_BMOD, I_GN1, I_GN2, I_WINAB, I_GQ, I_GK, I_WA2F, I_BAF, I_WA2B, I_BAB, I_GGLA, I_WOUTAB, I_WFFG, I_WFFU, I_WFFD, I_WINC, I_RPB, I_WOUTC, I_WROUTER, I_WMG, I_WMU, I_WMD, I_GFINAL };

struct Frame {
    LAS unsigned char* lds;
    int wave, vcu, G;
};

__device__ __forceinline__ const float* srow(const float* lat, const float* ctx, int r) {
    const int b = r / TOT, t = r - b * TOT;
    return t < NCTX ? ctx + (size_t)(b * NCTX + t) * DM : lat + (size_t)(b * SEQ + t - NCTX) * DM;
}

struct SchedAll {
    pg8::Deal D; unsigned rowbytes;
    __device__ __forceinline__ bool next(int i, pg8::Unit& u) const { int lm, j; if (!D.get(i, lm, j)) return false; u.pm = lm; u.pn = j; u.pc = j; u.po = lm; u.kb = 0; return true; }
    __device__ __forceinline__ unsigned arow(const pg8::Unit& u, int r) const { return (unsigned)(u.pm * 256 + r) * rowbytes; }
};
struct SchedLat {
    pg8::Deal D; unsigned rowbytes;
    __device__ __forceinline__ bool next(int i, pg8::Unit& u) const { int lm, j; if (!D.get(i, lm, j)) return false; u.pm = (lm >> 3) * 9 + 1 + (lm & 7); u.pn = j; u.pc = j; u.po = u.pm; u.kb = 0; return true; }
    __device__ __forceinline__ unsigned arow(const pg8::Unit& u, int r) const { return (unsigned)(u.pm * 256 + r) * rowbytes; }
};
struct SchedMoe1 {
    pg8::Deal D; int m0; int tb[8]; const int* rowidx;
    __device__ __forceinline__ int expert(int pm) const { int e = 0;
#pragma unroll
        for (int k = 1; k < 8; ++k) e += (pm >= tb[k]) ? 1 : 0;
        return e; }
    __device__ __forceinline__ bool next(int i, pg8::Unit& u) const { int lm, j; if (!D.get(i, lm, j)) return false; u.pm = m0 + lm; u.pn = expert(u.pm) * 28 + j; u.pc = j; u.po = lm; u.kb = 0; return true; }
    __device__ __forceinline__ unsigned arow(const pg8::Unit& u, int r) const {
        typedef int i32x16 __attribute__((ext_vector_type(16)));
        const int* p = rowidx + u.pm * 256 + __builtin_amdgcn_readfirstlane(r & ~15);
        i32x16 v; asm volatile("s_load_dwordx16 %0, %1, 0x0\n\ts_waitcnt lgkmcnt(0)" : "=s"(v) : "s"(p) : "memory");
        const int sel = r & 15; int x = v[0];
#pragma unroll
        for (int i = 1; i < 16; ++i) x = (sel == i) ? v[i] : x;
        return (unsigned)x * (unsigned)(DM * 2); }
};
struct SchedMoe2 {
    pg8::Deal D; int m0; int tb[8];
    __device__ __forceinline__ int expert(int pm) const { int e = 0;
#pragma unroll
        for (int k = 1; k < 8; ++k) e += (pm >= tb[k]) ? 1 : 0;
        return e; }
    __device__ __forceinline__ bool next(int i, pg8::Unit& u) const { int lm, j; if (!D.get(i, lm, j)) return false; u.pm = lm; u.pn = expert(m0 + lm) * 4 + j; u.pc = j; u.po = m0 + lm; u.kb = 0; return true; }
    __device__ __forceinline__ unsigned arow(const pg8::Unit& u, int r) const { return (unsigned)(u.pm * 256 + r) * (unsigned)(DFF * 2); }
};

struct SchedMoe2Split {
    int G, c, nT, m0; int tb[8];
    __device__ __forceinline__ int expert(int pm) const { int e = 0;
#pragma unroll
        for (int k = 1; k < 8; ++k) e += (pm >= tb[k]) ? 1 : 0;
        return e; }
    __device__ __forceinline__ bool next(int i, pg8::Unit& u) const { const int L = i * G + c; if (L >= nT * 16) return false;
        const int lm = L >> 4, j = (L >> 2) & 3, ks = L & 3; u.pm = lm; u.pn = expert(m0 + lm) * 4 + j; u.pc = j + 4 * ks; u.po = lm; u.kb = ks * (DFF / 4) * 2; return true; }
    __device__ __forceinline__ unsigned arow(const pg8::Unit& u, int r) const { return (unsigned)(u.pm * 256 + r) * (unsigned)(DFF * 2) + (unsigned)u.kb; }
};

struct SchedCtxSplit {
    int G, c, ksub; unsigned rowbytes;
    __device__ __forceinline__ bool next(int i, pg8::Unit& u) const { const int L = i * G + c; if (L >= 16 * 16) return false;
        const int lm = L >> 4, j = (L >> 2) & 3, ks = L & 3; u.pm = lm * 9; u.pn = j; u.pc = j + 4 * ks; u.po = u.pm; u.kb = ks * ksub * 2; return true; }
    __device__ __forceinline__ unsigned arow(const pg8::Unit& u, int r) const { return (unsigned)(u.pm * 256 + r) * rowbytes + (unsigned)u.kb; }
};

struct EpiBf16 {
    pg8::bf16_t* O; int ldc; int nscale; float scale;
    __device__ __forceinline__ void operator()(const pg8::f32x4 (&acc)[2][2][4][2], const pg8::Unit& u, int wr, int wc) const {
        const int lane_ = lane_id(), fr = lane_ & 15, fq = lane_ >> 4;
        const int row0 = u.po * 256 + wr * 64 + fr, col0 = u.pc * 256 + wc * 32 + 8 * fq;
        const float sc = (u.pc < nscale) ? scale : 1.f;
#pragma unroll
        for (int ai = 0; ai < 2; ++ai)
#pragma unroll
            for (int m = 0; m < 4; ++m) { pg8::bf16_t* rowp = O + (size_t)(row0 + ai * 128 + m * 16) * ldc + col0;
#pragma unroll
                for (int bj = 0; bj < 2; ++bj) { const pg8::f32x4 v0 = acc[ai][bj][m][0] * sc, v1 = acc[ai][bj][m][1] * sc;
                    pg8::u32x4 w; w.x = pg8::cvt_pk_bf16(v0[0], v0[1]); w.y = pg8::cvt_pk_bf16(v0[2], v0[3]); w.z = pg8::cvt_pk_bf16(v1[0], v1[1]); w.w = pg8::cvt_pk_bf16(v1[2], v1[3]);
                    *(pg8::u32x4*)(rowp + bj * 128) = w; } }
    }
};
struct EpiSwiglu {
    pg8::bf16_t* O; int ldc;
    __device__ __forceinline__ void operator()(const pg8::f32x4 (&acc)[2][2][4][2], const pg8::Unit& u, int wr, int wc) const {
        const int lane_ = lane_id(), fr = lane_ & 15, fq = lane_ >> 4;
        const int row0 = u.po * 256 + wr * 64 + fr, col0 = u.pc * 128 + wc * 32 + 8 * fq;
#pragma unroll
        for (int ai = 0; ai < 2; ++ai)
#pragma unroll
            for (int m = 0; m < 4; ++m) { pg8::bf16_t* rowp = O + (size_t)(row0 + ai * 128 + m * 16) * ldc + col0;
                float a[8];
#pragma unroll
                for (int n = 0; n < 2; ++n)
#pragma unroll
                    for (int e = 0; e < 4; ++e) a[n * 4 + e] = silu_f(acc[ai][0][m][n][e]) * acc[ai][1][m][n][e];
                pg8::u32x4 w; w.x = pg8::cvt_pk_bf16(a[0], a[1]); w.y = pg8::cvt_pk_bf16(a[2], a[3]); w.z = pg8::cvt_pk_bf16(a[4], a[5]); w.w = pg8::cvt_pk_bf16(a[6], a[7]);
                *(pg8::u32x4*)rowp = w; }
    }
};
__device__ __forceinline__ pg8::f32x4 bf4lo(unsigned a, unsigned b) { return (pg8::f32x4){__builtin_bit_cast(float, a << 16), __builtin_bit_cast(float, a & 0xffff0000u), __builtin_bit_cast(float, b << 16), __builtin_bit_cast(float, b & 0xffff0000u)}; }
template <bool SRCF32>
struct EpiResid {
    const void* src_lat; const void* src_ctx; pg8::bf16_t* dst_lat; pg8::bf16_t* dst_ctx; const float* mod; int gchunk;
    __device__ __forceinline__ void operator()(const pg8::f32x4 (&acc)[2][2][4][2], const pg8::Unit& u, int wr, int wc) const {
        const int lane_ = lane_id(), fr = lane_ & 15, fq = lane_ >> 4;
        const int b = u.po / 9, j = u.po - b * 9;
        const char* s; pg8::bf16_t* d; const float* gt; size_t o;
        if (j == 0) { o = (size_t)b * NCTX * DM; s = (const char*)src_ctx; d = dst_ctx; gt = mod + 16 * 6144 + gchunk * DM; }
        else { o = ((size_t)b * SEQ + (size_t)(j - 1) * 256) * DM; s = (const char*)src_lat; d = dst_lat; gt = mod + b * 6144 + gchunk * DM; }
        const int row0 = wr * 64 + fr, col0 = u.pc * 256 + wc * 32 + 8 * fq;
        pg8::f32x4 gv[2][2];
#pragma unroll
        for (int bj = 0; bj < 2; ++bj)
#pragma unroll
            for (int n = 0; n < 2; ++n) gv[bj][n] = *(const pg8::f32x4*)(gt + col0 + bj * 128 + 4 * n);
#pragma unroll
        for (int ai = 0; ai < 2; ++ai)
#pragma unroll
            for (int m = 0; m < 4; ++m) { const size_t ro = o + (size_t)(row0 + ai * 128 + m * 16) * DM + col0;
#pragma unroll
                for (int bj = 0; bj < 2; ++bj) { pg8::f32x4 x0, x1;
                    if constexpr (SRCF32) { const float* sp = (const float*)s + ro + bj * 128; x0 = *(const pg8::f32x4*)sp; x1 = *(const pg8::f32x4*)(sp + 4); }
                    else { const pg8::u32x4 w = *(const pg8::u32x4*)((const pg8::bf16_t*)s + ro + bj * 128); x0 = bf4lo(w.x, w.y); x1 = bf4lo(w.z, w.w); }
                    const pg8::f32x4 r0 = x0 + gv[bj][0] * acc[ai][bj][m][0], r1 = x1 + gv[bj][1] * acc[ai][bj][m][1];
                    pg8::u32x4 wv; wv.x = pg8::cvt_pk_bf16(r0[0], r0[1]); wv.y = pg8::cvt_pk_bf16(r0[2], r0[3]); wv.z = pg8::cvt_pk_bf16(r1[0], r1[1]); wv.w = pg8::cvt_pk_bf16(r1[2], r1[3]);
                    *(pg8::u32x4*)(d + ro + bj * 128) = wv; } }
    }
};

struct EpiPartF32 {
    static constexpr int NST = 32;
    float* part;
    __device__ __forceinline__ void operator()(const pg8::f32x4 (&acc)[2][2][4][2], const pg8::Unit& u, int wr, int wc) const {
        const int lane_ = lane_id(), fr = lane_ & 15, fq = lane_ >> 4;
        float* d = part + ((size_t)(u.pc >> 2) * 2048 + (size_t)u.po * 256) * DM;
        const int row0 = wr * 64 + fr, col0 = (u.pc & 3) * 256 + wc * 32 + 8 * fq;
#pragma unroll
        for (int ai = 0; ai < 2; ++ai)
#pragma unroll
            for (int m = 0; m < 4; ++m) { const size_t ro = (size_t)(row0 + ai * 128 + m * 16) * DM + col0;
#pragma unroll
                for (int bj = 0; bj < 2; ++bj)
#pragma unroll
                    for (int n = 0; n < 2; ++n) *(pg8::f32x4*)(d + ro + bj * 128 + 4 * n) = acc[ai][bj][m][n]; }
    }
};

struct EpiCtxSplit {
    static constexpr int NST = 0;
    const pg8::bf16_t* src_ctx; pg8::bf16_t* dst_ctx; const float* gate; float* part;
    __device__ __forceinline__ void operator()(const pg8::f32x4 (&acc)[2][2][4][2], const pg8::Unit& u, int wr, int wc) const {
        const int lane_ = lane_id(), fr = lane_ & 15, fq = lane_ >> 4;
        const int b = u.po / 9, ks = u.pc >> 2;
        const int row0 = wr * 64 + fr, col0 = (u.pc & 3) * 256 + wc * 32 + 8 * fq;
        if (ks == 0) {
            const pg8::bf16_t* s = src_ctx + (size_t)b * NCTX * DM; pg8::bf16_t* d = dst_ctx + (size_t)b * NCTX * DM;
            pg8::f32x4 gv[2][2];
#pragma unroll
            for (int bj = 0; bj < 2; ++bj)
#pragma unroll
                for (int n = 0; n < 2; ++n) gv[bj][n] = *(const pg8::f32x4*)(gate + col0 + bj * 128 + 4 * n);
#pragma unroll
            for (int ai = 0; ai < 2; ++ai)
#pragma unroll
                for (int m = 0; m < 4; ++m) { const size_t ro = (size_t)(row0 + ai * 128 + m * 16) * DM + col0;
#pragma unroll
                    for (int bj = 0; bj < 2; ++bj) { const pg8::u32x4 w = *(const pg8::u32x4*)(s + ro + bj * 128);
                        const pg8::f32x4 r0 = bf4lo(w.x, w.y) + gv[bj][0] * acc[ai][bj][m][0], r1 = bf4lo(w.z, w.w) + gv[bj][1] * acc[ai][bj][m][1];
                        pg8::u32x4 wv; wv.x = pg8::cvt_pk_bf16(r0[0], r0[1]); wv.y = pg8::cvt_pk_bf16(r0[2], r0[3]); wv.z = pg8::cvt_pk_bf16(r1[0], r1[1]); wv.w = pg8::cvt_pk_bf16(r1[2], r1[3]);
                        *(pg8::u32x4*)(d + ro + bj * 128) = wv; } }
        } else {
            float* d = part + ((size_t)(ks - 1) * (NB * NCTX) + (size_t)b * NCTX) * DM;
#pragma unroll
            for (int ai = 0; ai < 2; ++ai)
#pragma unroll
                for (int m = 0; m < 4; ++m) { const size_t ro = (size_t)(row0 + ai * 128 + m * 16) * DM + col0;
#pragma unroll
                    for (int bj = 0; bj < 2; ++bj)
#pragma unroll
                        for (int n = 0; n < 2; ++n) *(pg8::f32x4*)(d + ro + bj * 128 + 4 * n) = acc[ai][bj][m][n]; }
        }
    }
};

__device__ __forceinline__ void transpose_item(const float* W, int K, int N, bf16* WT, int drow0, int k0, int n0, LAS float* scr, int lane) {
    float tv[32];
    const float* Wl = W + (size_t)(k0 + (lane >> 5)) * N + n0 + (lane & 31);
#pragma unroll
    for (int i = 0; i < 32; ++i) tv[i] = __builtin_nontemporal_load(Wl + (size_t)(2 * i) * N);
#pragma unroll
    for (int i = 0; i < 32; ++i) scr[(2 * i + (lane >> 5)) * 33 + (lane & 31)] = tv[i];
    LDS_WAIT(); asm volatile("" ::: "memory");
    const int c = lane & 7;
#pragma unroll
    for (int j = 0; j < 4; ++j) { const int n = (lane >> 3) + 8 * j; const LAS float* s = scr + (8 * c) * 33 + n;
        v4u o; o.x = pk2(s[0 * 33], s[1 * 33]); o.y = pk2(s[2 * 33], s[3 * 33]); o.z = pk2(s[4 * 33], s[5 * 33]); o.w = pk2(s[6 * 33], s[7 * 33]);
        *(GAS v4u*)(WT + (size_t)(drow0 + n) * K + k0 + 8 * c) = o; }
    LDS_WAIT(); asm volatile("" ::: "memory");
}
__device__ __forceinline__ void tr_plain(const float* W, int K, int N, bf16* WT, int row_off, int item, LAS float* scr, int lane) {
    const int nblk = N / 32, kb = item / nblk, nb = item - kb * nblk;
    transpose_item(W, K, N, WT, row_off + 32 * nb, 64 * kb, 32 * nb, scr, lane);
}
__device__ __forceinline__ void tr_gu(const float* W, int K, int N, bf16* WT, int row_off, int up, int item, LAS float* scr, int lane) {
    const int nblk = N / 32, kb = item / nblk, nb = item - kb * nblk, n0 = 32 * nb;
    transpose_item(W, K, N, WT, row_off + (n0 >> 7) * 256 + up * 128 + (n0 & 127), 64 * kb, n0, scr, lane);
}

__device__ __forceinline__ void p0_prologue(const Frame& F, const Args& a) {
    const int F_lane = lane_id(), F_tid = F.wave * 64 + F_lane; (void)F_tid;
    unsigned char* ws = a.ws;
    {
        LAS float* sc = (LAS float*)F.lds;
        LAS float* part = (LAS float*)(F.lds + 17 * 1024 * 4);
        bool loaded = false;
        for (int u = blockIdx.x; u < 192; u += F.G) {
            if (!loaded) {
                for (int i = F_tid; i < 17 * 1024; i += NTHR) { const float v = (i < 16 * 1024) ? a.in[I_C][i] : a.in[I_CCTX][i - 16 * 1024]; sc[i] = silu_f(v); }
                loaded = true;
            }
            __syncthreads();
            const int l = u / 96, cb = u - l * 96;
            const float* W = a.in[I_WMOD] + (size_t)l * DM * 6144 + cb * 64 + F_lane;
            float acc[17];
#pragma unroll
            for (int r = 0; r < 17; ++r) acc[r] = 0.f;
            const int k0 = F.wave * 128;
#pragma unroll 4
            for (int k = 0; k < 128; ++k) { const float w = W[(size_t)(k0 + k) * 6144];
#pragma unroll
                for (int r = 0; r < 17; ++r) acc[r] += sc[r * 1024 + k0 + k] * w; }
#pragma unroll
            for (int r = 0; r < 17; ++r) part[(F.wave * 17 + r) * 64 + F_lane] = acc[r];
            __syncthreads();
            float* MOD = (float*)(ws + WS_MOD) + (size_t)l * 17 * 6144;
            for (int o = F_tid; o < 17 * 64; o += NTHR) { const int r = o >> 6, c = o & 63; float s = a.in[I_BMOD][l * 6144 + cb * 64 + c];
#pragma unroll
                for (int w = 0; w < 8; ++w) s += part[(w * 17 + r) * 64 + c];
                MOD[r * 6144 + cb * 64 + c] = s; }
        }
        __syncthreads();
    }
    LAS float* scr = (LAS float*)(F.lds + F.wave * 16384);
    const int gw = F.vcu * NWAVES + F.wave, NGW = F.G * NWAVES;
    constexpr int I_AB = 16 * 73, I_SQ = 16 * 32, I_FG = 16 * 112, I_FD = 56 * 32, I_IC = 16 * 96;
    constexpr int NITEMS = I_AB + I_SQ + 2 * I_FG + I_FD + I_IC + I_SQ;
    for (int it = gw; it < NITEMS; it += NGW) {
        int r = it;
        if (r < I_AB) { tr_plain(a.in[I_WINAB], DM, ABW, (bf16*)(ws + WS_WINAB), 0, r, scr, F_lane); continue; } r -= I_AB;
        if (r < I_SQ) { tr_plain(a.in[I_WOUTAB], DM, DM, (bf16*)(ws + WS_WOUTAB), 0, r, scr, F_lane); continue; } r -= I_SQ;
        if (r < I_FG) { tr_gu(a.in[I_WFFG], DM, DFF, (bf16*)(ws + WS_WFF1), 0, 0, r, scr, F_lane); continue; } r -= I_FG;
        if (r < I_FG) { tr_gu(a.in[I_WFFU], DM, DFF, (bf16*)(ws + WS_WFF1), 0, 1, r, scr, F_lane); continue; } r -= I_FG;
        if (r < I_FD) { tr_plain(a.in[I_WFFD], DFF, DM, (bf16*)(ws + WS_WFF2), 0, r, scr, F_lane); continue; } r -= I_FD;
        if (r < I_IC) { tr_plain(a.in[I_WINC], DM, QKVW, (bf16*)(ws + WS_WINC), 0, r, scr, F_lane); continue; } r -= I_IC;
        tr_plain(a.in[I_WOUTC], DM, DM, (bf16*)(ws + WS_WOUTC), 0, r, scr, F_lane);
    }
    { GAS v4u* z = (GAS v4u*)(ws + WS_WINAB + (size_t)ABW * DM * 2); const int n16 = (ABP - ABW) * DM * 2 / 16;
      for (int i = blockIdx.x * NTHR + F_tid; i < n16; i += F.G * NTHR) z[i] = (v4u){0u, 0u, 0u, 0u}; }
}

__device__ __forceinline__ void moe_weights_convert(const Frame& F, const Args& a, int first, int count) {
    const int F_lane = lane_id(), F_tid = F.wave * 64 + F_lane; (void)F_tid;
    const int me = (int)blockIdx.x - first; if (me < 0 || me >= count) return;
    unsigned char* ws = a.ws;
    LAS float* scr = (LAS float*)(F.lds + F.wave * 16384);
    constexpr int I_FG = 16 * 112, I_FD = 56 * 32, PER = 2 * I_FG + I_FD;
    for (int it = me * NWAVES + F.wave; it < 8 * PER; it += count * NWAVES) {
        const int e = it / PER; int r = it - e * PER;
        if (r < I_FG) { tr_gu(a.in[I_WMG] + (size_t)e * DM * DFF, DM, DFF, (bf16*)(ws + WS_WMOE1), e * 2 * DFF, 0, r, scr, F_lane); continue; } r -= I_FG;
        if (r < I_FG) { tr_gu(a.in[I_WMU] + (size_t)e * DM * DFF, DM, DFF, (bf16*)(ws + WS_WMOE1), e * 2 * DFF, 1, r, scr, F_lane); continue; } r -= I_FG;
        tr_plain(a.in[I_WMD] + (size_t)e * DFF * DM, DFF, DM, (bf16*)(ws + WS_WMOE2), e * DM, r, scr, F_lane);
    }
}

__device__ __forceinline__ void norm_mod_row(const float* xrow, const float* g, const float* sh, const float* scl, bf16* orow, int lane, f32x4 (&hv)[4]) {
    const GAS f32x4* xr = (const GAS f32x4*)xrow + lane;
    float s = 0.f;
#pragma unroll
    for (int j = 0; j < 4; ++j) { hv[j] = xr[64 * j]; s += (hv[j].x * hv[j].x + hv[j].y * hv[j].y) + (hv[j].z * hv[j].z + hv[j].w * hv[j].w); }
    const float rstd = 1.f / sqrtf(wave_sum(s) * (1.f / DM) + EPS);
    GAS v2u* o8 = (GAS v2u*)orow + lane;
#pragma unroll
    for (int j = 0; j < 4; ++j) {
        const f32x4 gg = ((const GAS f32x4*)g)[64 * j + lane], s1 = ((const GAS f32x4*)scl)[64 * j + lane], s0 = ((const GAS f32x4*)sh)[64 * j + lane];
        hv[j] = hv[j] * rstd * gg * (s1 + 1.f) + s0;
        v2u w; w.x = pk2(hv[j].x, hv[j].y); w.y = pk2(hv[j].z, hv[j].w); o8[64 * j] = w;
    }
}
__device__ __forceinline__ void norm_mod_vals(const float* g, const float* sh, const float* scl, bf16* orow, int lane, f32x4 (&hv)[4]) {
    float s = 0.f;
#pragma unroll
    for (int j = 0; j < 4; ++j) s += (hv[j].x * hv[j].x + hv[j].y * hv[j].y) + (hv[j].z * hv[j].z + hv[j].w * hv[j].w);
    const float rstd = 1.f / sqrtf(wave_sum(s) * (1.f / DM) + EPS);
    GAS v2u* o8 = (GAS v2u*)orow + lane;
#pragma unroll
    for (int j = 0; j < 4; ++j) { const f32x4 gg = ((const GAS f32x4*)g)[64 * j + lane], s1 = ((const GAS f32x4*)scl)[64 * j + lane], s0 = ((const GAS f32x4*)sh)[64 * j + lane];
        const f32x4 h = hv[j] * rstd * gg * (s1 + 1.f) + s0; v2u w; w.x = pk2(h.x, h.y); w.y = pk2(h.z, h.w); o8[64 * j] = w; }
}
template <bool XBF>
__device__ __forceinline__ void norm_mod_rows4(const void* const (&xrow)[4], const float* g, const float* sh, const float* scl, bf16* const (&orow)[4], int lane, f32x4 (&hv)[4][4]) {
#pragma unroll
    for (int q = 0; q < 4; ++q) {
        if constexpr (XBF) { const GAS v2u* xr = (const GAS v2u*)xrow[q] + lane;
#pragma unroll
            for (int j = 0; j < 4; ++j) { const v2u w = __builtin_nontemporal_load(xr + 64 * j); hv[q][j] = (f32x4){bflo(w.x), bfhi(w.x), bflo(w.y), bfhi(w.y)}; } }
        else { const GAS f32x4* xr = (const GAS f32x4*)xrow[q] + lane;
#pragma unroll
            for (int j = 0; j < 4; ++j) hv[q][j] = __builtin_nontemporal_load(xr + 64 * j); } }
    f32x4 gg[4], s1[4], s0[4];
#pragma unroll
    for (int j = 0; j < 4; ++j) { gg[j] = ((const GAS f32x4*)g)[64 * j + lane]; s1[j] = ((const GAS f32x4*)scl)[64 * j + lane] + 1.f; s0[j] = ((const GAS f32x4*)sh)[64 * j + lane]; gg[j] = gg[j] * s1[j]; }
#pragma unroll
    for (int q = 0; q < 4; ++q) { float s = 0.f;
#pragma unroll
        for (int j = 0; j < 4; ++j) s += (hv[q][j].x * hv[q][j].x + hv[q][j].y * hv[q][j].y) + (hv[q][j].z * hv[q][j].z + hv[q][j].w * hv[q][j].w);
        const float rstd = 1.f / sqrtf(wave_sum(s) * (1.f / DM) + EPS);
        GAS v2u* o8 = (GAS v2u*)orow[q] + lane;
#pragma unroll
        for (int j = 0; j < 4; ++j) { hv[q][j] = hv[q][j] * rstd * gg[j] + s0[j]; v2u w; w.x = pk2(hv[q][j].x, hv[q][j].y); w.y = pk2(hv[q][j].z, hv[q][j].w); o8[64 * j] = w; } }
}
template <bool XBF>
__device__ __forceinline__ void norm_phase(const Frame& F, const Args& a, int l, int which, const void* lat, const void* ctx, const float* gvec, const float* pgate) {
    const int F_lane = lane_id(), F_tid = F.wave * 64 + F_lane; (void)F_tid;
    const float* MOD = (const float*)(a.ws + WS_MOD) + (size_t)l * 17 * 6144;
    bf16* HB = (bf16*)a.out;
    const int gw = F.vcu * NWAVES + F.wave, NGW = F.G * NWAVES;
    for (int r4 = gw; r4 < MROWS / 4; r4 += NGW) {
        const int r = 4 * r4, b = r / TOT, t = r - b * TOT;
        const float* m = MOD + (t < NCTX ? 16 : b) * 6144 + which * 3 * DM;
        if (pgate && t < NCTX) {
            const float* PART = (const float*)(a.ws + WS_PARTC);
#pragma unroll
            for (int q = 0; q < 4; ++q) { const size_t cr = (size_t)(b * NCTX + t + q) * DM; const GAS v2u* xr = (const GAS v2u*)((const bf16*)ctx + cr) + F_lane; f32x4 hv[4];
#pragma unroll
                for (int j = 0; j < 4; ++j) { const f32x4 p1 = ((const GAS f32x4*)(PART + cr))[64 * j + F_lane], p2 = ((const GAS f32x4*)(PART + (size_t)NB * NCTX * DM + cr))[64 * j + F_lane], p3 = ((const GAS f32x4*)(PART + 2 * (size_t)NB * NCTX * DM + cr))[64 * j + F_lane];
                    const f32x4 g = ((const GAS f32x4*)pgate)[64 * j + F_lane]; const v2u w = xr[64 * j]; hv[j] = (f32x4){bflo(w.x), bfhi(w.x), bflo(w.y), bfhi(w.y)} + g * ((p1 + p2) + p3); }
                norm_mod_vals(gvec, m, m + DM, HB + (size_t)(r + q) * DM, F_lane, hv); }
            continue; }
        const size_t xo = (t < NCTX ? (size_t)(b * NCTX + t) : (size_t)(b * SEQ + t - NCTX)) * DM * (XBF ? 2 : 4), xp = (size_t)DM * (XBF ? 2 : 4);
        const char* x0 = (const char*)(t < NCTX ? ctx : lat) + xo;
        const void* const xr[4] = {x0, x0 + xp, x0 + 2 * xp, x0 + 3 * xp};
        bf16* const orw[4] = {HB + (size_t)r * DM, HB + (size_t)(r + 1) * DM, HB + (size_t)(r + 2) * DM, HB + (size_t)(r + 3) * DM};
        f32x4 hv[4][4];
        norm_mod_rows4<XBF>(xr, gvec, m, m + DM, orw, F_lane, hv);
    }
}

__device__ __forceinline__ void qkprep_phase(const Frame& F, const Args& a) {
    const int lane = lane_id(), g = lane >> 4, l16 = lane & 15;
    bf16* P = (bf16*)(a.ws + WS_PROJ0);
    const int gw = F.vcu * NWAVES + F.wave, NGW = F.G * NWAVES;
    const f32x4 gq = *(const GAS f32x4*)(a.in[I_GQ] + 4 * l16), gk = *(const GAS f32x4*)(a.in[I_GK] + 4 * l16);
    const float inv0 = fexp2(-(float)((2 * l16) & 15) * (13.287712379549449f / 16.f)), inv1 = fexp2(-(float)((2 * l16 + 1) & 15) * (13.287712379549449f / 16.f));
    for (int r4 = gw; r4 < MROWS / 4; r4 += NGW) {
        v2u raw[10];
#pragma unroll
        for (int p = 0; p < 10; ++p) { const int s = 4 * p + g, rl = s / 10, hv = s - rl * 10; raw[p] = *(const GAS v2u*)(P + (size_t)(4 * r4 + rl) * ABP + hv * 64 + 4 * l16); }
#pragma unroll
        for (int p = 0; p < 10; ++p) { const int s = 4 * p + g, rl = s / 10, hv = s - rl * 10, r = 4 * r4 + rl, b = r / TOT, t = r - b * TOT;
            f32x4 v = {bflo(raw[p].x), bfhi(raw[p].x), bflo(raw[p].y), bfhi(raw[p].y)};
            float ss = (v.x * v.x + v.y * v.y) + (v.z * v.z + v.w * v.w);
#pragma unroll
            for (int o = 1; o < 16; o <<= 1) ss += __shfl_xor(ss, o);
            const float rs = 1.f / sqrtf(ss * (1.f / 64.f) + EPS) * (hv < 8 ? 0.125f * LOG2E : 1.f);
            v = v * rs * (hv < 8 ? gq : gk);
            if (t >= NCTX) { const int tl = t - NCTX; const float pos = (float)((l16 < 8) ? (tl >> 6) : (tl & 63));
                const float rv0 = pos * inv0 * 0.15915494309189535f, rv1 = pos * inv1 * 0.15915494309189535f; const float f0 = rv0 - floorf(rv0), f1 = rv1 - floorf(rv1);
                const float c0 = __builtin_amdgcn_cosf(f0), s0 = __builtin_amdgcn_sinf(f0), c1 = __builtin_amdgcn_cosf(f1), s1 = __builtin_amdgcn_sinf(f1);
                v = (f32x4){v.x * c0 - v.y * s0, v.x * s0 + v.y * c0, v.z * c1 - v.w * s1, v.z * s1 + v.w * c1}; }
            v2u w; w.x = pk2(v.x, v.y); w.y = pk2(v.z, v.w);
            *(GAS v2u*)(P + (size_t)r * ABP + hv * 64 + 4 * l16) = w; }
    }
}

typedef float f32x2_cv __attribute__((ext_vector_type(2))); typedef __bf16 bf16x2_cv __attribute__((ext_vector_type(2)));
__device__ __forceinline__ unsigned cvt_pk_c(float lo, float hi) { const f32x2_cv v = {lo, hi}; const bf16x2_cv b = __builtin_convertvector(v, bf16x2_cv); return __builtin_bit_cast(unsigned, b); }
__device__ __forceinline__ void gla_mfma_phase(const Frame& F, const Args& a) {
    typedef short bf16x8 __attribute__((ext_vector_type(8)));
    typedef short s16x4 __attribute__((ext_vector_type(4)));
    typedef short v4i16_t __attribute__((ext_vector_type(4)));
    typedef float f32x16 __attribute__((ext_vector_type(16)));
    constexpr int PT = 72, PV = 136;
    const bf16* P = (const bf16*)(a.ws + WS_PROJ0);
    LAS bf16* Qd = (LAS bf16*)F.lds;
    LAS bf16* Ki = Qd + 64 * PT;
    LAS bf16* Vv = Ki + 64 * PT;
    LAS bf16* ST = Vv + 64 * PV;
    LAS float* dec = (LAS float*)(ST + 2 * 128 * PT);
    LAS float* w2s = dec + 64;
    LAS bf16* Ob = (LAS bf16*)(w2s + 17 * 64);
    const int lane = lane_id(), w = F.wave, tid = w * 64 + lane, r32 = lane & 31, hi = lane >> 5;
    const int trr = (lane & 15) >> 2, trc = 16 * ((lane >> 4) & 1) + 4 * (lane & 3);
#define GLA_TR(p) __builtin_bit_cast(s16x4, __builtin_amdgcn_ds_read_tr16_b64_v4i16((LAS v4i16_t*)(p)))
#define GLA_CAT(lo, hi4) (bf16x8){lo[0], lo[1], lo[2], lo[3], hi4[0], hi4[1], hi4[2], hi4[3]}
#define GLA_CROW(r) (((r) & 3) + 8 * ((r) >> 2) + 4 * hi)
    for (int u = blockIdx.x; u < 128; u += F.G) {
        const int dir = u & 1, h = (u >> 1) & 3, b = u >> 3;
        const float* w2 = a.in[dir ? I_WA2B : I_WA2F]; const float* ba = a.in[dir ? I_BAB : I_BAF];
        bf16* O = (bf16*)(a.ws + (dir ? WS_GLAR : WS_GLAF));
        __syncthreads();
        for (int i = tid; i < 17 * 64; i += NTHR) w2s[i] = (i < 1024) ? w2[(i >> 6) * 256 + h * 64 + (i & 63)] : ba[h * 64 + (i & 63)];
        for (int i = tid; i < 128 * PT / 2; i += NTHR) ((LAS unsigned*)ST)[i] = 0u;
        f32x16 S;
#pragma unroll
        for (int r = 0; r < 16; ++r) S[r] = 0.f;
        v4u rq, rk, rz0, rz1, rv0, rv1;
        const int vtok = tid >> 3, vseg = tid & 7;
#define GLA_TOK(p) (dir == 0 ? (p) : ((p) < NCTX ? NCTX - 1 - (p) : TOT + NCTX - 1 - (p)))
#define GLA_LOAD(n) do { const bf16* rowA = P + (size_t)(b * TOT + GLA_TOK((n) * 64 + lane)) * ABP; const bf16* rowB = P + (size_t)(b * TOT + GLA_TOK((n) * 64 + vtok)) * ABP; \
        rq = *(const GAS v4u*)(rowA + PB_Q + h * 64 + 8 * w); rk = *(const GAS v4u*)(rowA + PB_K + h * 64 + 8 * w); rz0 = *(const GAS v4u*)(rowA + PZ_F + dir * 16); rz1 = *(const GAS v4u*)(rowA + PZ_F + dir * 16 + 8); \
        rv0 = *(const GAS v4u*)(rowB + PB_V + h * 128 + 16 * vseg); rv1 = *(const GAS v4u*)(rowB + PB_V + h * 128 + 16 * vseg + 8); } while (0)
        GLA_LOAD(0);
        for (int n = 0; n < TOT / 64; ++n) {
            LDS_BARRIER();
            if (n > 0) { const v4u ov0 = *(const LAS v4u*)(Ob + vtok * PV + 16 * vseg), ov1 = *(const LAS v4u*)(Ob + vtok * PV + 16 * vseg + 8);
                bf16* op = O + (size_t)(b * TOT + GLA_TOK((n - 1) * 64 + vtok)) * 512 + h * 128 + 16 * vseg; *(GAS v4u*)op = ov0; *(GAS v4u*)(op + 8) = ov1; }
            {
                float z[16];
                z[0] = bflo(rz0.x); z[1] = bfhi(rz0.x); z[2] = bflo(rz0.y); z[3] = bfhi(rz0.y); z[4] = bflo(rz0.z); z[5] = bfhi(rz0.z); z[6] = bflo(rz0.w); z[7] = bfhi(rz0.w);
                z[8] = bflo(rz1.x); z[9] = bfhi(rz1.x); z[10] = bflo(rz1.y); z[11] = bfhi(rz1.y); z[12] = bflo(rz1.z); z[13] = bfhi(rz1.z); z[14] = bflo(rz1.w); z[15] = bfhi(rz1.w);
                f32x4 u0 = *(const LAS f32x4*)(w2s + 1024 + 8 * w), u1 = *(const LAS f32x4*)(w2s + 1024 + 8 * w + 4);
#pragma unroll
                for (int rb = 0; rb < 16; rb += 8) {
                    f32x4 wa[8], wb[8];
#pragma unroll
                    for (int r = 0; r < 8; ++r) { wa[r] = *(const LAS f32x4*)(w2s + (rb + r) * 64 + 8 * w); wb[r] = *(const LAS f32x4*)(w2s + (rb + r) * 64 + 8 * w + 4); }
                    asm volatile("s_waitcnt lgkmcnt(0)" ::: "memory");
#pragma unroll
                    for (int r = 0; r < 8; ++r) { u0 += wa[r] * z[rb + r]; u1 += wb[r] * z[rb + r]; } }
                float la[8];
#pragma unroll
                for (int c = 0; c < 8; ++c) { const float uu = c < 4 ? u0[c & 3] : u1[c & 3]; la[c] = -(fmaxf(-uu, 0.f) * LOG2E + __builtin_amdgcn_logf(1.f + fexp2(-fabsf(uu) * LOG2E))) * (1.f / 16.f); }
#pragma unroll
                for (int o = 1; o < 64; o <<= 1) {
#pragma unroll
                    for (int c = 0; c < 8; ++c) { const float nb = __shfl_up(la[c], o, 64); if (lane >= o) la[c] += nb; } }
                float qv[8], kv[8];
                qv[0] = bflo(rq.x); qv[1] = bfhi(rq.x); qv[2] = bflo(rq.y); qv[3] = bfhi(rq.y); qv[4] = bflo(rq.z); qv[5] = bfhi(rq.z); qv[6] = bflo(rq.w); qv[7] = bfhi(rq.w);
                kv[0] = bflo(rk.x); kv[1] = bfhi(rk.x); kv[2] = bflo(rk.y); kv[3] = bfhi(rk.y); kv[4] = bflo(rk.z); kv[5] = bfhi(rk.z); kv[6] = bflo(rk.w); kv[7] = bfhi(rk.w);
#pragma unroll
                for (int c = 0; c < 8; ++c) { qv[c] *= 0.125f * fexp2(la[c]); kv[c] *= fexp2(-la[c]); }
                v4u wq, wk; wq.x = cvt_pk_c(qv[0], qv[1]); wq.y = cvt_pk_c(qv[2], qv[3]); wq.z = cvt_pk_c(qv[4], qv[5]); wq.w = cvt_pk_c(qv[6], qv[7]);
                wk.x = cvt_pk_c(kv[0], kv[1]); wk.y = cvt_pk_c(kv[2], kv[3]); wk.z = cvt_pk_c(kv[4], kv[5]); wk.w = cvt_pk_c(kv[6], kv[7]);
                *(LAS v4u*)(Qd + lane * PT + 8 * w) = wq; *(LAS v4u*)(Ki + lane * PT + 8 * w) = wk;
                if (lane == 63) {
#pragma unroll
                    for (int c = 0; c < 8; ++c) dec[8 * w + c] = fexp2(la[c]); }
                *(LAS v4u*)(Vv + vtok * PV + 16 * vseg) = rv0; *(LAS v4u*)(Vv + vtok * PV + 16 * vseg + 8) = rv1;
            }
            LDS_BARRIER();
            if (n + 1 < TOT / 64) GLA_LOAD(n + 1);
            LAS bf16* STc = ST + (n & 1) * 128 * PT; LAS bf16* STn = ST + ((n + 1) & 1) * 128 * PT;
            {
                const int j = w >> 2, c = w & 3;
                bf16x8 qf[4];
#pragma unroll
                for (int ks = 0; ks < 4; ++ks) qf[ks] = *(const LAS bf16x8*)(Qd + (32 * j + r32) * PT + 16 * ks + 8 * hi);
                f32x16 o;
#pragma unroll
                for (int r = 0; r < 16; ++r) o[r] = 0.f;
                for (int i = 0; i <= j; ++i) {
                    f32x16 X;
#pragma unroll
                    for (int r = 0; r < 16; ++r) X[r] = 0.f;
#pragma unroll
                    for (int ks = 0; ks < 4; ++ks) { const bf16x8 kf = *(const LAS bf16x8*)(Ki + (32 * i + r32) * PT + 16 * ks + 8 * hi); X = __builtin_amdgcn_mfma_f32_32x32x16_bf16(kf, qf[ks], X, 0, 0, 0); }
                    if (i == j) {
#pragma unroll
                        for (int r = 0; r < 16; ++r) X[r] = (GLA_CROW(r) > r32) ? 0.f : X[r]; }
#pragma unroll
                    for (int sp = 0; sp < 2; ++sp) {
                        v4u pw; pw.x = cvt_pk_c(X[8 * sp + 0], X[8 * sp + 1]); pw.y = cvt_pk_c(X[8 * sp + 2], X[8 * sp + 3]); pw.z = cvt_pk_c(X[8 * sp + 4], X[8 * sp + 5]); pw.w = cvt_pk_c(X[8 * sp + 6], X[8 * sp + 7]);
                        const LAS bf16* vp = Vv + (32 * i + 16 * sp + 4 * hi + trr) * PV + 32 * c + trc;
                        const s16x4 lo = GLA_TR(vp), hi4 = GLA_TR(vp + 8 * PV);
                        o = __builtin_amdgcn_mfma_f32_32x32x16_bf16(__builtin_bit_cast(bf16x8, pw), GLA_CAT(lo, hi4), o, 0, 0, 0);
                    }
                }
#pragma unroll
                for (int ks = 0; ks < 4; ++ks) { const bf16x8 sf = *(const LAS bf16x8*)(STc + (32 * c + r32) * PT + 16 * ks + 8 * hi); o = __builtin_amdgcn_mfma_f32_32x32x16_bf16(qf[ks], sf, o, 0, 0, 0); }
#pragma unroll
                for (int r = 0; r < 16; ++r) Ob[(32 * j + GLA_CROW(r)) * PV + 32 * c + r32] = (bf16)f2bf(o[r]);
            }
            {
                const int a2 = w >> 2, c = w & 3;
#pragma unroll
                for (int ks = 0; ks < 4; ++ks) {
                    const LAS bf16* kp = Ki + (16 * ks + 8 * hi + trr) * PT + 32 * a2 + trc; const LAS bf16* vp = Vv + (16 * ks + 8 * hi + trr) * PV + 32 * c + trc;
                    const s16x4 alo = GLA_TR(kp), ahi = GLA_TR(kp + 4 * PT), blo = GLA_TR(vp), bhi = GLA_TR(vp + 4 * PV);
                    S = __builtin_amdgcn_mfma_f32_32x32x16_bf16(GLA_CAT(alo, ahi), GLA_CAT(blo, bhi), S, 0, 0, 0);
                }
#pragma unroll
                for (int g = 0; g < 4; ++g) { const f32x4 dv = *(const LAS f32x4*)(dec + 32 * a2 + 8 * g + 4 * hi);
                    S[4 * g + 0] *= dv.x; S[4 * g + 1] *= dv.y; S[4 * g + 2] *= dv.z; S[4 * g + 3] *= dv.w;
                    v2u pw; pw.x = cvt_pk_c(S[4 * g + 0], S[4 * g + 1]); pw.y = cvt_pk_c(S[4 * g + 2], S[4 * g + 3]);
                    *(LAS v2u*)(STn + (32 * c + r32) * PT + 32 * a2 + 8 * g + 4 * hi) = pw; }
            }
        }
        __syncthreads();
        { const v4u ov0 = *(const LAS v4u*)(Ob + vtok * PV + 16 * vseg), ov1 = *(const LAS v4u*)(Ob + vtok * PV + 16 * vseg + 8);
          bf16* op = O + (size_t)(b * TOT + GLA_TOK((TOT / 64 - 1) * 64 + vtok)) * 512 + h * 128 + 16 * vseg; *(GAS v4u*)op = ov0; *(GAS v4u*)(op + 8) = ov1; }
#undef GLA_LOAD
#undef GLA_TOK
    }
#undef GLA_TR
#undef GLA_CAT
#undef GLA_CROW
    __syncthreads();
}

__device__ __forceinline__ void gla_combine_phase(const Frame& F, const Args& a) {
    const int F_lane = lane_id(), F_tid = F.wave * 64 + F_lane; (void)F_tid;
    const bf16* P = (const bf16*)(a.ws + WS_PROJ0);
    const bf16* Of = (const bf16*)(a.ws + WS_GLAF); const bf16* Or = (const bf16*)(a.ws + WS_GLAR);
    bf16* O = (bf16*)a.out;
    const int gw = F.vcu * NWAVES + F.wave, NGW = F.G * NWAVES;
    float gg[8];
#pragma unroll
    for (int i = 0; i < 8; ++i) gg[i] = a.in[I_GGLA][(F_lane & 15) * 8 + i];
    for (int r = gw; r < MROWS; r += NGW) {
        const v4u wf = *(const GAS v4u*)(Of + (size_t)r * 512 + F_lane * 8), wr_ = *(const GAS v4u*)(Or + (size_t)r * 512 + F_lane * 8);
        const v4u wg = *(const GAS v4u*)(P + (size_t)r * ABP + PB_R + F_lane * 8);
        float x[8], rb[8];
        x[0] = bflo(wf.x) + bflo(wr_.x); x[1] = bfhi(wf.x) + bfhi(wr_.x); x[2] = bflo(wf.y) + bflo(wr_.y); x[3] = bfhi(wf.y) + bfhi(wr_.y);
        x[4] = bflo(wf.z) + bflo(wr_.z); x[5] = bfhi(wf.z) + bfhi(wr_.z); x[6] = bflo(wf.w) + bflo(wr_.w); x[7] = bfhi(wf.w) + bfhi(wr_.w);
        rb[0] = bflo(wg.x); rb[1] = bfhi(wg.x); rb[2] = bflo(wg.y); rb[3] = bfhi(wg.y); rb[4] = bflo(wg.z); rb[5] = bfhi(wg.z); rb[6] = bflo(wg.w); rb[7] = bfhi(wg.w);
        float ss = 0.f;
#pragma unroll
        for (int i = 0; i < 8; ++i) ss += x[i] * x[i];
#pragma unroll
        for (int o = 1; o < 16; o <<= 1) ss += __shfl_xor(ss, o);
        const float rs = 1.f / sqrtf(ss * (1.f / 128.f) + EPS);
        float y[8];
#pragma unroll
        for (int i = 0; i < 8; ++i) y[i] = x[i] * rs * gg[i] * silu_f(rb[i]);
        v4u w; w.x = pk2(y[0], y[1]); w.y = pk2(y[2], y[3]); w.z = pk2(y[4], y[5]); w.w = pk2(y[6], y[7]);
        *(GAS v4u*)(O + (size_t)r * DM + 512 + F_lane * 8) = w;
    }
}

__device__ __forceinline__ void attnA_phase(const Frame& F, const Args& a, char* lds) {
    const attn_body::bf16* P = (const attn_body::bf16*)(a.ws + WS_PROJ0);
    attn_body::bf16* O = (attn_body::bf16*)a.out;
    for (int u = F.vcu; u < 1024 + 128; u += F.G) {
        int b, h, kvh, NT; long qrow;
        if (u < 1024) { const int grp = u >> 5, w = u & 31; b = grp >> 1; kvh = grp & 1; h = kvh * 4 + (w >> 3); qrow = (long)b * TOT + NCTX + (w & 7) * 256; NT = TOT / 64; }
        else { const int v = u - 1024; b = v >> 3; h = v & 7; kvh = h >> 2; qrow = (long)b * TOT; NT = NCTX / 64; }
        const attn_body::bf16* Kh = P + (long)b * TOT * ABP + PA_K + kvh * 64;
        attn_body::attn_unit<8, ABP, DM, false>(P + qrow * ABP + PA_Q + h * 64, Kh, Kh + (PA_V - PA_K), O + qrow * DM + h * 64, NT, lds, 0, 0, nullptr, F.wave);
    }
}
__device__ __forceinline__ void na_phase(const Frame& F, const Args& a, char* lds) {
    const attn_body::bf16* Q = (const attn_body::bf16*)(a.ws + WS_QKV);
    attn_body::bf16* O = (attn_body::bf16*)a.out;
    int h_built = -1;
    for (int i = 0;; ++i) {
        const int u = F.vcu + i * F.G; if (u >= NB * 16 * 8) break;
        const int bh = u >> 3, r0g = ((u & 7) + i) & 7, b = bh >> 4, h = bh & 15;
        if (h != h_built) { attn_body::na_bias_tables(lds, a.in[I_RPB] + h * 465, F.wave * 64 + lane_id()); h_built = h; __syncthreads(); }
        const int klo = r0g == 0 ? 0 : (r0g == 7 ? 24 : 4 * r0g - 4), NT = (r0g == 0 || r0g == 7) ? 12 : 16;
        const long qrow = (long)b * TOT + NCTX + r0g * 256;
        const attn_body::bf16* Kh = Q + (long)b * TOT * QKVW + DM + h * 64;
        attn_body::attn_unit<8, QKVW, DM, true>(Q + qrow * QKVW + h * 64, Kh, Kh + DM, O + qrow * DM + h * 64, NT, lds, klo, 4 * r0g, a.in[I_RPB] + h * 465, F.wave);
    }
}
__device__ __forceinline__ void router_phase(const Frame& F, const Args& a) {
    const int F_lane = lane_id(), F_tid = F.wave * 64 + F_lane; (void)F_tid;
    const float* MOD = (const float*)(a.ws + WS_MOD) + (size_t)17 * 6144;
    bf16* HB = (bf16*)a.out;
    int* RE = (int*)(a.ws + WS_RE); float* RG = (float*)(a.ws + WS_RG); int* CNT = (int*)(a.ws + WS_CNT);
    LAS float* wr = (LAS float*)F.lds;
    LAS int* sel = (LAS int*)(F.lds + 32768);
    for (int i = F_tid; i < DM * 8; i += NTHR) { const int kk = i >> 3, e = i & 7, g = (kk >> 8) * 4 + (kk & 3), lk = (kk >> 2) & 63; wr[((g * 2 + (e >> 2)) * 64 + lk) * 4 + (e & 3)] = a.in[I_WROUTER][i]; }
    for (int q = blockIdx.x; q < NLAT / 128; q += F.G) {
        __syncthreads();
        for (int i4 = 0; i4 < 4; ++i4) {
            const int tok0 = q * 128 + F.wave * 16 + 4 * i4, b = tok0 >> 11, tl0 = tok0 & 2047;
            const int r0 = b * TOT + NCTX + tl0;
            const float* m = MOD + b * 6144 + 3 * DM;
            const bf16* x0 = (const bf16*)(a.ws + WS_XL) + (size_t)tok0 * DM;
            const void* const xr[4] = {x0, x0 + DM, x0 + 2 * DM, x0 + 3 * DM};
            bf16* const orw[4] = {HB + (size_t)r0 * DM, HB + (size_t)(r0 + 1) * DM, HB + (size_t)(r0 + 2) * DM, HB + (size_t)(r0 + 3) * DM};
            f32x4 hv4[4][4];
            norm_mod_rows4<true>(xr, a.in[I_GN2] + DM, m, m + DM, orw, F_lane, hv4);
#pragma unroll
            for (int qq = 0; qq < 4; ++qq) {
            const int tok = tok0 + qq, i = 4 * i4 + qq;
            float lg[8];
#pragma unroll
            for (int e = 0; e < 8; ++e) lg[e] = 0.f;
#pragma unroll
            for (int j = 0; j < 4; ++j)
#pragma unroll
                for (int c = 0; c < 4; ++c) { const int g = j * 4 + c; const f32x4 w0 = *(const LAS f32x4*)(wr + ((g * 2) * 64 + F_lane) * 4), w1 = *(const LAS f32x4*)(wr + ((g * 2 + 1) * 64 + F_lane) * 4); const float hh = hv4[qq][j][c];
                    lg[0] += hh * w0.x; lg[1] += hh * w0.y; lg[2] += hh * w0.z; lg[3] += hh * w0.w; lg[4] += hh * w1.x; lg[5] += hh * w1.y; lg[6] += hh * w1.z; lg[7] += hh * w1.w; }
#pragma unroll
            for (int e = 0; e < 8; ++e) lg[e] = wave_sum(lg[e]);
            int e0 = 0; float v0 = lg[0];
#pragma unroll
            for (int e = 1; e < 8; ++e) if (lg[e] > v0) { v0 = lg[e]; e0 = e; }
            int e1 = -1; float v1 = -3.0e38f;
#pragma unroll
            for (int e = 0; e < 8; ++e) if (e != e0 && lg[e] > v1) { v1 = lg[e]; e1 = e; }
            const float g0 = frcp(1.f + fexp2((v1 - v0) * LOG2E));
            if (F_lane == 0) { RE[tok * 2] = e0; RE[tok * 2 + 1] = e1; RG[tok * 2] = g0; RG[tok * 2 + 1] = 1.f - g0; sel[(F.wave * 16 + i) * 2] = e0; sel[(F.wave * 16 + i) * 2 + 1] = e1; }
            }
        }
        __syncthreads();
        if (F_tid < 8) { int c = 0; for (int i = 0; i < 256; ++i) c += (sel[i] == F_tid) ? 1 : 0; CNT[q * 8 + F_tid] = c; }
    }
    __syncthreads();
}

__device__ __forceinline__ void slots_phase(const Frame& F, const Args& a) {
    const int F_lane = lane_id(), F_tid = F.wave * 64 + F_lane; (void)F_tid;
    const int* RE = (const int*)(a.ws + WS_RE); const int* CNT = (const int*)(a.ws + WS_CNT);
    int* SLOT = (int*)(a.ws + WS_SLOT); int* ROWIDX = (int*)(a.ws + WS_ROWIDX); int* TB = (int*)(a.ws + WS_TB);
    LAS int* cn = (LAS int*)F.lds;
    LAS int* ptot = cn + 2048;
    LAS int* ppre = ptot + 512;
    LAS int* tot = ppre + 512;
    LAS int* pre = tot + 8;
    LAS int* base = pre + 8;
    LAS int* sel = base + 16;
    for (int q = blockIdx.x; q < NLAT / 128; q += F.G) {
        __syncthreads();
        for (int i = F_tid; i < 2048; i += NTHR) cn[i] = CNT[i];
        if (F_tid < 256) sel[F_tid] = RE[q * 256 + F_tid];
        __syncthreads();
        { const int e = F_tid & 7, seg = F_tid >> 3; int t = 0, p = 0;
#pragma unroll
          for (int j = 0; j < 4; ++j) { const int w = seg * 4 + j, c = cn[w * 8 + e]; t += c; p += (w < q) ? c : 0; }
          ptot[seg * 8 + e] = t; ppre[seg * 8 + e] = p; }
        __syncthreads();
        if (F_tid < 8) { int t = 0, p = 0;
#pragma unroll 8
            for (int s = 0; s < 64; ++s) { t += ptot[s * 8 + F_tid]; p += ppre[s * 8 + F_tid]; }
            tot[F_tid] = t; pre[F_tid] = p; }
        __syncthreads();
        if (F_tid == 0) { int bs = 0; for (int e = 0; e < 8; ++e) { base[e] = bs; bs += (tot[e] + 255) & ~255; } base[8] = bs; }
        __syncthreads();
        if (F_tid < 8) { const int e = F_tid; int s = base[e] + pre[e];
            for (int i = 0; i < 256; ++i) if (sel[i] == e) { const int tok = q * 128 + (i >> 1); SLOT[q * 256 + i] = s; ROWIDX[s] = (tok >> 11) * TOT + NCTX + (tok & 2047); ++s; } }
        if (q == 0) {
            if (F_tid < 9) TB[F_tid] = base[F_tid] >> 8;
            for (int e = 0; e < 8; ++e) for (int s = base[e] + tot[e] + F_tid; s < base[e + 1]; s += NTHR) ROWIDX[s] = NCTX;
        }
    }
    __syncthreads();
}

__device__ __forceinline__ v2u tail_y(const GAS v2u* yrow_lane, const float* PART, int slot, int j, int lane) {
    constexpr int TAIL0 = (MOE_NCHUNK - 1) * MOE_CHUNK * 256;
    if (slot < TAIL0) return yrow_lane[64 * j];
    const GAS f32x4* p = (const GAS f32x4*)(PART + (size_t)(slot - TAIL0) * DM) + 64 * j + lane; const size_t st = (size_t)2048 * DM / 4;
    const f32x4 s = (p[0] + p[st]) + (p[2 * st] + p[3 * st]);
    v2u w; w.x = pk2(s.x, s.y); w.y = pk2(s.z, s.w); return w;
}
__device__ __forceinline__ void final_phase(const Frame& F, const Args& a) {
    const int F_lane = lane_id(), F_tid = F.wave * 64 + F_lane; (void)F_tid;
    const float* MOD = (const float*)(a.ws + WS_MOD) + (size_t)17 * 6144;
    const bf16* YA = (const bf16*)(a.ws + WS_YA); const bf16* YB = (const bf16*)(a.ws + WS_YB) - (size_t)32768 * DM; const float* PART = (const float*)(a.ws + WS_PART);
    const int* SLOT = (const int*)(a.ws + WS_SLOT); const float* RG = (const float*)(a.ws + WS_RG);
    const int gw = F.vcu * NWAVES + F.wave, NGW = F.G * NWAVES;
    for (int t2 = gw; t2 < NLAT / 2; t2 += NGW) {
        const int tok0 = 2 * t2, b = tok0 >> 11;
        const float* gt = MOD + b * 6144 + 5 * DM;
        const v4u sl = *(const GAS v4u*)(SLOT + tok0 * 2); const f32x4 rg = *(const GAS f32x4*)(RG + tok0 * 2);
        const int s0[2] = {(int)sl.x, (int)sl.z}, s1[2] = {(int)sl.y, (int)sl.w};
        const float g0[2] = {rg.x, rg.z}, g1[2] = {rg.y, rg.w};
        f32x4 x[2][4]; v2u ya[2][4], yb[2][4];
#pragma unroll
        for (int q = 0; q < 2; ++q) { const GAS v2u* xr = (const GAS v2u*)((const bf16*)(a.ws + WS_XL) + (size_t)(tok0 + q) * DM) + F_lane;
            const GAS v2u* y0 = (const GAS v2u*)((s0[q] < 32768 ? YA : YB) + (size_t)s0[q] * DM) + F_lane; const GAS v2u* y1 = (const GAS v2u*)((s1[q] < 32768 ? YA : YB) + (size_t)s1[q] * DM) + F_lane;
#pragma unroll
            for (int j = 0; j < 4; ++j) { const v2u w = xr[64 * j]; x[q][j] = (f32x4){bflo(w.x), bfhi(w.x), bflo(w.y), bfhi(w.y)}; ya[q][j] = tail_y(y0, PART, s0[q], j, F_lane); yb[q][j] = tail_y(y1, PART, s1[q], j, F_lane); } }
#pragma unroll
        for (int q = 0; q < 2; ++q) { float ss = 0.f;
#pragma unroll
            for (int j = 0; j < 4; ++j) { const v2u a0 = ya[q][j], a1 = yb[q][j]; const f32x4 gv = ((const GAS f32x4*)gt)[64 * j + F_lane];
                f32x4 mo; mo.x = g0[q] * bflo(a0.x) + g1[q] * bflo(a1.x); mo.y = g0[q] * bfhi(a0.x) + g1[q] * bfhi(a1.x); mo.z = g0[q] * bflo(a0.y) + g1[q] * bflo(a1.y); mo.w = g0[q] * bfhi(a0.y) + g1[q] * bfhi(a1.y);
                x[q][j] = x[q][j] + gv * mo; ss += (x[q][j].x * x[q][j].x + x[q][j].y * x[q][j].y) + (x[q][j].z * x[q][j].z + x[q][j].w * x[q][j].w); }
            const float rstd = 1.f / sqrtf(wave_sum(ss) * (1.f / DM) + EPS);
            GAS f32x4* xw = (GAS f32x4*)(a.out + (size_t)(tok0 + q) * DM) + F_lane;
#pragma unroll
            for (int j = 0; j < 4; ++j) { const f32x4 gf = ((const GAS f32x4*)a.in[I_GFINAL])[64 * j + F_lane]; xw[64 * j] = x[q][j] * rstd * gf; } }
    }
}

constexpr int NPHASE = 16 + 2 * MOE_NCHUNK;
__global__ void __launch_bounds__(NTHR, 2) fwd(Args args) {
    extern __shared__ __attribute__((aligned(16))) unsigned char lds[];
    Frame F;
    F.lds = (LAS unsigned char*)lds;
    F.wave = __builtin_amdgcn_readfirstlane((int)threadIdx.x >> 6);
    F.G = gridDim.x; { const int bx = blockIdx.x; F.vcu = (F.G % 8 == 0) ? (bx % 8) * (F.G / 8) + bx / 8 : bx; }
    unsigned char* ws = args.ws;
    for (int u = F.wave * 64 + lane_id(); u < (LDS_BYTES - LDSCTL_OFF) / 4; u += NTHR) ((LAS unsigned*)(F.lds + LDSCTL_OFF))[u] = 0u;
    __syncthreads();
#if MK_ONE_LAUNCH
    XcdBarrier bar = xcd_barrier_post((unsigned*)(ws + WS_CTL) + CW_BAR, (volatile LAS unsigned*)(F.lds + MISC_OFF) + 8);
#define GRID_BAR() xcd_barrier(bar)
#else
#define GRID_BAR() do {} while (0)
#endif
    const int lo = args.ph_lo, hi = args.ph_hi;
#define IN(k) (lo <= (k) && (k) < hi)
#define SEAM(k) do { if (IN(k) && IN((k) + 1)) GRID_BAR(); } while (0)
    const float* MOD0 = (const float*)(ws + WS_MOD); const float* MOD1 = MOD0 + 17 * 6144;
    pg8::bf16_t* const RA = (pg8::bf16_t*)args.out;
    pg8::bf16_t* const XL = (pg8::bf16_t*)(ws + WS_XL); pg8::bf16_t* const XC = (pg8::bf16_t*)(ws + WS_XC);

    if (IN(0)) { p0_prologue(F, args); SEAM(0); }
    if (IN(1)) { norm_phase<false>(F, args, 0, 0, args.in[I_X], args.in[I_CTX], args.in[I_GN1], nullptr); SEAM(1); }
    if (IN(2)) {
        pg8::Gemm g{RA, (const pg8::bf16_t*)(ws + WS_WINAB), DM, DM}; SchedAll S; S.D.init(MROWS / 256, ABP / 256, F.G, (int)blockIdx.x); S.rowbytes = DM * 2;
        EpiBf16 E{(pg8::bf16_t*)(ws + WS_PROJ0), ABP, 0, 1.f};
        pg8::gemm_phase<EpiBf16, SchedAll, true>(F.lds, F.wave, g, S, E); SEAM(2); }
    if (IN(3)) { qkprep_phase(F, args); gla_mfma_phase(F, args);
        { const int first = F.G > 128 ? 128 : 0; moe_weights_convert(F, args, first, F.G - first); }
        SEAM(3); }
    if (IN(4)) { attnA_phase(F, args, (char*)lds); gla_combine_phase(F, args); SEAM(4); }
    if (IN(5)) {
        pg8::Gemm g{RA, (const pg8::bf16_t*)(ws + WS_WOUTAB), DM, DM}; SchedAll S; S.D.init(MROWS / 256, DM / 256, F.G, (int)blockIdx.x); S.rowbytes = DM * 2;
        EpiResid<true> E{args.in[I_X], args.in[I_CTX], XL, XC, MOD0, 2};
        pg8::gemm_phase<EpiResid<true>, SchedAll, true>(F.lds, F.wave, g, S, E); SEAM(5); }
    if (IN(6)) { norm_phase<true>(F, args, 0, 1, XL, XC, args.in[I_GN2], nullptr); SEAM(6); }
    if (IN(7)) {
        pg8::Gemm g{RA, (const pg8::bf16_t*)(ws + WS_WFF1), DM, DM}; SchedAll S; S.D.init(MROWS / 256, 2 * DFF / 256, F.G, (int)blockIdx.x); S.rowbytes = DM * 2;
        EpiSwiglu E{(pg8::bf16_t*)(ws + WS_ACT), DFF};
        pg8::gemm_phase<EpiSwiglu, SchedAll, true>(F.lds, F.wave, g, S, E); SEAM(7); }
    if (IN(8)) {
        { pg8::Gemm g{(const pg8::bf16_t*)(ws + WS_ACT), (const pg8::bf16_t*)(ws + WS_WFF2), DFF, DFF}; SchedLat S; S.D.init(NLAT / 256, DM / 256, F.G, (int)blockIdx.x); S.rowbytes = DFF * 2;
          EpiResid<false> E{XL, XC, XL, XC, MOD0, 5};
          pg8::gemm_phase<EpiResid<false>, SchedLat, true>(F.lds, F.wave, g, S, E); }
        { pg8::Gemm g{(const pg8::bf16_t*)(ws + WS_ACT), (const pg8::bf16_t*)(ws + WS_WFF2), DFF / 4, DFF}; SchedCtxSplit S{F.G, (int)blockIdx.x, DFF / 4, DFF * 2};
          EpiCtxSplit E{XC, XC, MOD0 + 16 * 6144 + 5 * DM, (float*)(ws + WS_PARTC)};
          pg8::gemm_phase<EpiCtxSplit, SchedCtxSplit, true>(F.lds, F.wave, g, S, E); }
        SEAM(8); }
    if (IN(9)) { norm_phase<true>(F, args, 1, 0, XL, XC, args.in[I_GN1] + DM, MOD0 + 16 * 6144 + 5 * DM); SEAM(9); }
    if (IN(10)) {
        pg8::Gemm g{RA, (const pg8::bf16_t*)(ws + WS_WINC), DM, DM}; SchedAll S; S.D.init(MROWS / 256, QKVW / 256, F.G, (int)blockIdx.x); S.rowbytes = DM * 2;
        EpiBf16 E{(pg8::bf16_t*)(ws + WS_QKV), QKVW, 4, C2};
        pg8::gemm_phase<EpiBf16, SchedAll, true>(F.lds, F.wave, g, S, E); SEAM(10); }
    if (IN(11)) { na_phase(F, args, (char*)lds); SEAM(11); }
    if (IN(12)) {
        pg8::Gemm g{RA, (const pg8::bf16_t*)(ws + WS_WOUTC), DM, DM}; SchedLat S; S.D.init(NLAT / 256, DM / 256, F.G, (int)blockIdx.x); S.rowbytes = DM * 2;
        EpiResid<false> E{XL, XC, XL, XC, MOD1, 2};
        pg8::gemm_phase<EpiResid<false>, SchedLat, true>(F.lds, F.wave, g, S, E); SEAM(12); }
    if (IN(13)) { router_phase(F, args); SEAM(13); }
    if (IN(14)) { slots_phase(F, args); SEAM(14); }
    for (int st = 0; st < MOE_NCHUNK; ++st) {
        const int c = st == 0 ? MOE_NCHUNK - 1 : st - 1;
        const int* TB = (const int*)(ws + WS_TB);
        if (IN(15 + 2 * st)) {
            SchedMoe1 S; const int T = TB[8]; const int m0 = c * MOE_CHUNK; int nMc = T - m0; nMc = nMc < 0 ? 0 : (nMc > MOE_CHUNK ? MOE_CHUNK : nMc);
#pragma unroll
            for (int k = 0; k < 8; ++k) S.tb[k] = TB[k];
            S.m0 = m0; S.rowidx = (const int*)(ws + WS_ROWIDX); S.D.init(nMc, 2 * DFF / 256, F.G, (int)blockIdx.x);
            pg8::Gemm g{RA, (const pg8::bf16_t*)(ws + WS_WMOE1), DM, DM};
            EpiSwiglu E{(pg8::bf16_t*)(ws + WS_ACTC), DFF};
            pg8::gemm_phase<EpiSwiglu, SchedMoe1, true>(F.lds, F.wave, g, S, E); SEAM(15 + 2 * st); }
        if (IN(16 + 2 * st)) {
            SchedMoe2 S; const int T = TB[8]; const int m0 = c * MOE_CHUNK; int nMc = T - m0; nMc = nMc < 0 ? 0 : (nMc > MOE_CHUNK ? MOE_CHUNK : nMc);
#pragma unroll
            for (int k = 0; k < 8; ++k) S.tb[k] = TB[k];
            if (c < MOE_NCHUNK - 1) {
                S.m0 = m0; S.D.init(nMc, DM / 256, F.G, (int)blockIdx.x);
                pg8::Gemm g{(const pg8::bf16_t*)(ws + WS_ACTC), (const pg8::bf16_t*)(ws + WS_WMOE2), DFF, DFF};
                EpiBf16 E{c == 0 ? (pg8::bf16_t*)(ws + WS_YA) : (pg8::bf16_t*)(ws + WS_YB) - (size_t)32768 * DM, DM, 0, 1.f};
                pg8::gemm_phase<EpiBf16, SchedMoe2, true>(F.lds, F.wave, g, S, E);
            } else {
                SchedMoe2Split SS; SS.G = F.G; SS.c = (int)blockIdx.x; SS.nT = nMc; SS.m0 = m0;
#pragma unroll
                for (int k = 0; k < 8; ++k) SS.tb[k] = S.tb[k];
                pg8::Gemm g{(const pg8::bf16_t*)(ws + WS_ACTC), (const pg8::bf16_t*)(ws + WS_WMOE2), DFF / 4, DFF};
                EpiPartF32 E{(float*)(ws + WS_PART)};
                pg8::gemm_phase<EpiPartF32, SchedMoe2Split, true>(F.lds, F.wave, g, SS, E);
            }
            SEAM(16 + 2 * st); }
    }
    if (IN(NPHASE - 1)) { final_phase(F, args); }
#undef IN
#undef SEAM
}

extern "C" void kernel_launch(void* const* d_in, const int* in_sizes, int n_in, void* d_out, int out_size, void* d_ws, size_t ws_size, hipStream_t stream) {
    static int grid = 0;
    if (grid == 0) {
        if (n_in != 28 || out_size != NLAT * DM || ws_size < WS_END) { fprintf(stderr, "kernel_launch: unexpected problem (n_in %d, out %d, ws %zu < %zu)\n", n_in, out_size, ws_size, (size_t)WS_END); grid = -1; return; }
        int dev = 0, cus = 0, per_cu = 0;
        if (hipGetDevice(&dev) != hipSuccess || hipDeviceGetAttribute(&cus, hipDeviceAttributeMultiprocessorCount, dev) != hipSuccess) { grid = -1; return; }
        if (hipFuncSetAttribute((const void*)fwd, hipFuncAttributeMaxDynamicSharedMemorySize, LDS_BYTES) != hipSuccess) { fprintf(stderr, "kernel_launch: hipFuncSetAttribute failed\n"); grid = -1; return; }
        if (hipOccupancyMaxActiveBlocksPerMultiprocessor(&per_cu, (const void*)fwd, NTHR, LDS_BYTES) != hipSuccess || per_cu < 1) fprintf(stderr, "kernel_launch: occupancy query reports %d\n", per_cu);
        (void)hipGetLastError();
        grid = cus;
    }
    if (grid < 0) return;
    (void)hipMemsetAsync((char*)d_ws + WS_CTL, 0, CTL_ZERO_BYTES, stream);
    Args a{};
    for (int i = 0; i < 28; ++i) a.in[i] = (const float*)d_in[i];
    a.out = (float*)d_out; a.ws = (unsigned char*)d_ws;
#if MK_ONE_LAUNCH
    a.ph_lo = 0; a.ph_hi = NPHASE;
    hipLaunchKernelGGL(fwd, dim3(grid), dim3(NTHR), LDS_BYTES, stream, a);
#else
    for (int p = 0; p < NPHASE; ++p) { a.ph_lo = p; a.ph_hi = p + 1; hipLaunchKernelGGL(fwd, dim3(grid), dim3(NTHR), LDS_BYTES, stream, a); }
#endif
}
```

```cpp
#include <hip/hip_runtime.h>
#include <cstdio>
#include <cstdint>

#ifndef MK_ONE_LAUNCH
#define MK_ONE_LAUNCH 1
#endif

__device__ __forceinline__ int lane_id() { int l; asm volatile("v_mbcnt_lo_u32_b32 %0, -1, 0\n\tv_mbcnt_hi_u32_b32 %0, -1, %0" : "=v"(l)); return l; }
namespace pg8 {
#define PG8_LAS __attribute__((address_space(3)))
typedef unsigned short bf16_t;
typedef short bf16x8 __attribute__((ext_vector_type(8)));
typedef float f32x4 __attribute__((ext_vector_type(4)));
typedef unsigned u32x4 __attribute__((ext_vector_type(4)));
constexpr int BM = 256, BK = 64, HALF = 128, HTB = HALF * BK * 2, STAGE_BYTES = 8 * HTB, NXCD = 8, WGM = 8;

__host__ __device__ __forceinline__ int lds_byte(int r, int c) { const int st = (r >> 4) * 2 + (c >> 5), rr = r & 15, cc = c & 31, ob = rr * 64 + cc * 2; return st * 1024 + (ob ^ (((ob >> 9) & 1) << 5)); }
__host__ __device__ __forceinline__ void stage_rc(int b, int& R, int& C) { const int st = b / 1024, sb = b % 1024, swz = sb ^ (((sb >> 9) & 1) << 5); R = (st >> 1) * 16 + swz / 64; C = (st & 1) * 32 + (swz % 64) / 2; }
__host__ __device__ __forceinline__ int perm32(int rho) { const int n = rho >> 4, i = rho & 15; return 8 * (i >> 2) + 4 * n + (i & 3); }

struct Unit { int pm, pn, pc, po, kb; };
struct Gemm { const bf16_t* A; const bf16_t* Bt; int K, ldb; };

struct Deal {
    int nM, nN, nwg, G, c;
    __device__ __forceinline__ void init(int nM_, int nN_, int G_, int c_) { nM = nM_; nN = nN_; nwg = nM_ * nN_; G = G_; c = c_; }
    __device__ __forceinline__ bool get(int i, int& lm, int& j) const {
        const long L = (long)i * G + c; if (L >= nwg) return false;
        int wgid = (int)L; { const int q = nwg / NXCD, r = nwg % NXCD, xcd = wgid % NXCD, off = wgid / NXCD; wgid = (xcd < r ? xcd * (q + 1) : r * (q + 1) + (xcd - r) * q) + off; }
        const int nig = WGM * nN, gid = wgid / nig, fm = gid * WGM, gsz = (nM - fm) < WGM ? (nM - fm) : WGM;
        lm = fm + ((wgid % nig) % gsz); j = (wgid % nig) / gsz; return true;
    }
};

__device__ __forceinline__ unsigned cvt_pk_bf16(float lo, float hi) { unsigned r; asm volatile("v_cvt_pk_bf16_f32 %0, %1, %2" : "=v"(r) : "v"(lo), "v"(hi)); return r; }

template <class Epi, class Sched, bool ALIGN_EPI>
__device__ __forceinline__ void gemm_phase(PG8_LAS unsigned char* lds, const int wid, const Gemm g, const Sched& S, const Epi& E) {
    const int lane = lane_id(), tid = wid * 64 + lane, wr = wid >> 2, wc = wid & 3, fr = lane & 15, fq = lane >> 4;
    const int K = g.K, nt = K / BK, ldb = g.ldb;
    unsigned voffB[2];
#pragma unroll
    for (int i = 0; i < 2; ++i) { int R, C; stage_rc(tid * 16 + i * 8192, R, C); const int Rb = (R & ~31) + perm32(R & 31);
        voffB[i] = (unsigned)(Rb * ldb + C) * 2u; }
    const size_t kstep = (size_t)(BK * 2);
    const size_t hstep = (size_t)HALF * ldb * 2;
    const size_t tstep = 2 * hstep;
    const unsigned ldsw = (unsigned)wid * 1024u;
    const int aoff = lds_byte(wr * 64 + fr, fq * 8), boff = lds_byte(wc * 32 + fr, fq * 8);
#define PG8_SA(b, h) (((b) * 2 + (h)) * HTB)
#define PG8_SB(b, h) ((4 + (b) * 2 + (h)) * HTB)
#define PG8_STAGE(bufoff, gbase, voff) do { _Pragma("unroll") for (int _i = 0; _i < 2; ++_i) \
        __builtin_amdgcn_global_load_lds((const unsigned*)((const char*)(gbase) + (voff)[_i]), (PG8_LAS unsigned*)(lds + (bufoff) + ldsw + _i * 8192), 16, 0, 0); } while (0)
#define PG8_LDA(dst, b, h) do { _Pragma("unroll") for (int m = 0; m < 4; ++m) _Pragma("unroll") for (int k = 0; k < 2; ++k) dst[m][k] = *(const PG8_LAS bf16x8*)(lds + PG8_SA(b, h) + aoff + m * 2048 + k * 1024); } while (0)
#define PG8_LDB(dst, b, h) do { _Pragma("unroll") for (int n = 0; n < 2; ++n) _Pragma("unroll") for (int k = 0; k < 2; ++k) dst[n][k] = *(const PG8_LAS bf16x8*)(lds + PG8_SB(b, h) + boff + n * 2048 + k * 1024); } while (0)
#define PG8_MMA(ai, bj, At, Bt) do { __builtin_amdgcn_s_setprio(1); _Pragma("unroll") for (int m = 0; m < 4; ++m) _Pragma("unroll") for (int n = 0; n < 2; ++n) _Pragma("unroll") for (int k = 0; k < 2; ++k) \
        acc[ai][bj][m][n] = __builtin_amdgcn_mfma_f32_16x16x32_bf16(Bt[n][k], At[m][k], acc[ai][bj][m][n], 0, 0, 0); __builtin_amdgcn_s_setprio(0); } while (0)
#define PG8_WAIT_V(n) asm volatile("s_waitcnt vmcnt(" #n ")" ::: "memory")
#define PG8_WAIT_L(n) asm volatile("s_waitcnt lgkmcnt(" #n ")" ::: "memory")
#define PG8_BAR __builtin_amdgcn_s_barrier()
#define PG8_SCHED __builtin_amdgcn_sched_barrier(0)
#define PG8_AOFF(dst, u) do { const int t_ = wid * 64 + lane_id(); _Pragma("unroll") for (int _i = 0; _i < 2; ++_i) { int R_, C_; stage_rc(t_ * 16 + _i * 8192, R_, C_);     \
        _Pragma("unroll") for (int _h = 0; _h < 2; ++_h) dst[_h][_i] = S.arow(u, _h * HALF + R_) + (unsigned)C_ * 2u; } } while (0)
    Unit cur, nxt; int ui = 0;
    if (!S.next(0, cur)) return;
    f32x4 acc[2][2][4][2];
#pragma unroll
    for (int a = 0; a < 2; ++a)
#pragma unroll
        for (int b = 0; b < 2; ++b)
#pragma unroll
            for (int m = 0; m < 4; ++m)
#pragma unroll
                for (int n = 0; n < 2; ++n) acc[a][b][m][n] = (f32x4){0.f, 0.f, 0.f, 0.f};
    bf16x8 At[4][2], B0[2][2], B1[2][2];
    const char* const Ab = (const char*)g.A; const char* cB = (const char*)g.Bt + (size_t)cur.pn * tstep + cur.kb;
    unsigned vAc[2][2], vAn[2][2];
    PG8_AOFF(vAc, cur);
    PG8_STAGE(PG8_SB(0, 0), cB, voffB); PG8_STAGE(PG8_SB(0, 1), cB + hstep, voffB); PG8_STAGE(PG8_SA(0, 0), Ab, vAc[0]); PG8_STAGE(PG8_SA(0, 1), Ab, vAc[1]);
    if (wr == 1) PG8_BAR;
    PG8_WAIT_V(2); PG8_BAR;
    PG8_STAGE(PG8_SB(1, 0), cB + kstep, voffB); PG8_STAGE(PG8_SA(1, 0), Ab + kstep, vAc[0]); PG8_STAGE(PG8_SB(1, 1), cB + hstep + kstep, voffB);
    PG8_WAIT_V(6); PG8_BAR;
    for (;;) {
        const bool has_next = S.next(ui + 1, nxt);
        const char* nB = has_next ? (const char*)g.Bt + (size_t)nxt.pn * tstep + nxt.kb : cB;
        if (has_next && (nxt.pm != cur.pm || nxt.kb != cur.kb)) { PG8_AOFF(vAn, nxt); } else {
#pragma unroll
            for (int h = 0; h < 2; ++h)
#pragma unroll
                for (int i = 0; i < 2; ++i) vAn[h][i] = vAc[h][i]; }
        for (int t = 0; t < nt; t += 2) {
            const bool last = (t == nt - 2);
            const char* a1 = Ab + (size_t)(t + 1) * kstep;
            const char* a2 = last ? Ab : Ab + (size_t)(t + 2) * kstep; const char* b2 = last ? nB : cB + (size_t)(t + 2) * kstep;
            const char* a3 = a2 + kstep; const char* b3 = b2 + kstep;
            unsigned va2[2][2];
#pragma unroll
            for (int h = 0; h < 2; ++h)
#pragma unroll
                for (int i = 0; i < 2; ++i) va2[h][i] = last ? vAn[h][i] : vAc[h][i];
            PG8_LDB(B0, 0, 0); PG8_LDB(B1, 0, 1); PG8_SCHED; PG8_LDA(At, 0, 0); PG8_STAGE(PG8_SA(1, 1), a1, vAc[1]);
            PG8_WAIT_V(8); PG8_WAIT_L(0); PG8_BAR; PG8_MMA(0, 0, At, B0); PG8_MMA(0, 1, At, B1); PG8_BAR; PG8_SCHED;
            PG8_LDA(At, 0, 1); PG8_STAGE(PG8_SB(0, 0), b2, voffB); PG8_STAGE(PG8_SB(0, 1), b2 + hstep, voffB); PG8_STAGE(PG8_SA(0, 0), a2, va2[0]);
            PG8_WAIT_V(8); PG8_WAIT_L(0); PG8_BAR; PG8_MMA(1, 0, At, B0); PG8_MMA(1, 1, At, B1); PG8_BAR; PG8_SCHED;
            PG8_LDB(B0, 1, 0); PG8_LDB(B1, 1, 1); PG8_SCHED; PG8_LDA(At, 1, 0); PG8_STAGE(PG8_SA(0, 1), a2, va2[1]);
            PG8_WAIT_V(8); PG8_WAIT_L(0); PG8_BAR; PG8_MMA(0, 0, At, B0); PG8_MMA(0, 1, At, B1); PG8_BAR; PG8_SCHED;
            PG8_LDA(At, 1, 1); PG8_STAGE(PG8_SB(1, 0), b3, voffB); PG8_STAGE(PG8_SB(1, 1), b3 + hstep, voffB); PG8_STAGE(PG8_SA(1, 0), a3, va2[0]);
            PG8_WAIT_V(8); PG8_WAIT_L(0); PG8_BAR; PG8_MMA(1, 0, At, B0); PG8_MMA(1, 1, At, B1); PG8_BAR; PG8_SCHED;
        }
        if constexpr (ALIGN_EPI) { if (wr == 0) PG8_BAR; }
        E(acc, cur, wr, wc);
        if (!has_next) break;
#pragma unroll
        for (int a = 0; a < 2; ++a)
#pragma unroll
            for (int b = 0; b < 2; ++b)
#pragma unroll
                for (int m = 0; m < 4; ++m)
#pragma unroll
                    for (int n = 0; n < 2; ++n) acc[a][b][m][n] = (f32x4){0.f, 0.f, 0.f, 0.f};
        cur = nxt; cB = nB; ++ui;
#pragma unroll
        for (int h = 0; h < 2; ++h)
#pragma unroll
            for (int i = 0; i < 2; ++i) vAc[h][i] = vAn[h][i];
        if constexpr (ALIGN_EPI) { if (wr == 1) PG8_BAR; }
    }
    PG8_WAIT_V(0);
    if constexpr (!ALIGN_EPI) { if (wr == 0) PG8_BAR; }
    PG8_BAR;
#undef PG8_SA
#undef PG8_SB
#undef PG8_STAGE
#undef PG8_LDA
#undef PG8_LDB
#undef PG8_MMA
#undef PG8_WAIT_V
#undef PG8_WAIT_L
#undef PG8_BAR
#undef PG8_SCHED
#undef PG8_AOFF
}
}

#include <hip/hip_bf16.h>
#include <cmath>
namespace attn_body {
using bf16=__hip_bfloat16;
using bf16x8=__attribute__((ext_vector_type(8)))short;
using s16x4=__attribute__((ext_vector_type(4)))short;
using f32x16=__attribute__((ext_vector_type(16)))float;
using u32x4=__attribute__((ext_vector_type(4)))unsigned;
constexpr int D=64;
constexpr int NW=8,QBLK=32,QB=QBLK*NW,KVBLK=64;
constexpr int ATTN_UNIT_ROWS=QB;
__device__ __forceinline__ int crow(int r,int hi){return (r&3)+8*(r>>2)+4*hi;}
#define SBAR() __builtin_amdgcn_sched_barrier(0)
__device__ __forceinline__ void cmask(f32x16&p0,f32x16&p1,int jb,int qrel,int hi){
  const float NEG=-INFINITY; int kb=64*jb+4*hi;
  #pragma unroll
  for(int r=0;r<16;++r){int kv=kb+(r&3)+8*(r>>2); if(kv>qrel)p0[r]=NEG; if(kv+32>qrel)p1[r]=NEG;}
}

constexpr int NSLOT=3, SLOTB=8192;
constexpr int LDS_K=0, LDS_V=NSLOT*SLOTB, LDS_WS=2*NSLOT*SLOTB, LDS_OST=LDS_WS+NW*64*4, LDS_BYTES=LDS_OST+NW*4096;
constexpr int TBL_OFF=LDS_BYTES;
constexpr int NAT_Z=0, NAT_NI=64, NAT_TI=128, NAT_TIW=120, NAT_TE=NAT_TI+15*NAT_TIW, NAT_TEP=80, NAT_TES=8*NAT_TEP, NAT_N=NAT_TE+15*NAT_TES;
__device__ __forceinline__ void na_bias_tables(char*shm,const float*rpbh,int tid){
  __attribute__((address_space(3))) float*tw=(__attribute__((address_space(3))) float*)((__attribute__((address_space(3))) char*)shm+TBL_OFF);
  const float NINF=-__builtin_inff(), L2E=1.4426950408889634f;
  for(int i=tid;i<NAT_N;i+=512){ float v;
    if(i<NAT_NI)v=0.f; else if(i<NAT_TI)v=NINF;
    else if(i<NAT_TE){ const int j=i-NAT_TI, dr=j/NAT_TIW, idx=j-dr*NAT_TIW-44; v=(idx>=7&&idx<=22)?rpbh[dr*31+idx]*L2E:NINF; }
    else { const int j=i-NAT_TE, dr=j/NAT_TES, q=j-dr*NAT_TES, p=q/NAT_TEP, o=q-p*NAT_TEP;
      if(o<16){ const int idx=o-p+15; v=rpbh[dr*31+idx]*L2E; }
      else if(o<64)v=NINF;
      else { const int kc=o-16, qc=56+p, idx=kc-qc+15; v=(p>0&&idx>=0&&idx<=30)?rpbh[dr*31+idx]*L2E:NINF; } }
    tw[i]=v; }
}
__device__ __forceinline__ float mask1(float x,int m32,int idx){ const unsigned sel=(unsigned)__builtin_amdgcn_sbfe(m32,idx,1); return __uint_as_float((__float_as_uint(x)&sel)|(~sel&0xff800000u)); }
constexpr float C2=0.125f*1.4426950408889634f;
__device__ __forceinline__ void glds16(const void*gsrc,unsigned lds_dst){unsigned keep;
  asm volatile("s_mov_b32 %0, m0\n\ts_mov_b32 m0, %2\n\ts_nop 0\n\tglobal_load_lds_dwordx4 %1, off\n\ts_mov_b32 m0, %0":"=&s"(keep):"v"(gsrc),"s"(lds_dst):"memory");}
__device__ __forceinline__ float max3f(float a,float b,float c){float r;asm("v_max3_f32 %0, %1, %2, %3":"=v"(r):"v"(a),"v"(b),"v"(c));return r;}
__device__ __forceinline__ float max2f(float a,float b){float r;asm("v_max_f32_e32 %0, %1, %2":"=v"(r):"v"(a),"v"(b));return r;}
__device__ __forceinline__ float fadd_s(float a,float b){float r;asm("v_add_f32_e32 %0, %1, %2":"=v"(r):"v"(a),"v"(b));return r;}
__device__ __forceinline__ float fsub_s(float a,float b){float r;asm("v_sub_f32_e32 %0, %1, %2":"=v"(r):"v"(a),"v"(b));return r;}
typedef float f32x2_t __attribute__((ext_vector_type(2))); typedef __bf16 bf16x2_t __attribute__((ext_vector_type(2)));
__device__ __forceinline__ unsigned cvtpk_s(float lo,float hi){f32x2_t v={lo,hi};bf16x2_t b=__builtin_convertvector(v,bf16x2_t);return __builtin_bit_cast(unsigned,b);}
#define WAIT_BAR(N) asm volatile("s_waitcnt vmcnt(" #N ") lgkmcnt(0)\n\ts_barrier":::"memory")

__device__ __forceinline__ void qkt(f32x16&p0,f32x16&p1,const char*Kslot,const bf16x8*qr,const f32x16&negm,int r32,int hi){
  const char*kb=Kslot+hi*1024+r32*16;
  #pragma unroll
  for(int d0=0;d0<4;++d0){
    const bf16x8 b0=*reinterpret_cast<const bf16x8*>(kb+d0*2048);
    const bf16x8 b1=*reinterpret_cast<const bf16x8*>(kb+d0*2048+512);
    if(d0==0){p0=__builtin_amdgcn_mfma_f32_32x32x16_bf16(b0,qr[0],negm,0,0,0);p1=__builtin_amdgcn_mfma_f32_32x32x16_bf16(b1,qr[0],negm,0,0,0);}
    else{p0=__builtin_amdgcn_mfma_f32_32x32x16_bf16(b0,qr[d0],p0,0,0,0);p1=__builtin_amdgcn_mfma_f32_32x32x16_bf16(b1,qr[d0],p1,0,0,0);}}
}
typedef __attribute__((address_space(3))) const char* lds_cptr;
typedef short v4i16_t __attribute__((ext_vector_type(4)));
__device__ __forceinline__ void kload8(bf16x8*kf,lds_cptr kp){
  kf[0]=*(const __attribute__((address_space(3))) bf16x8*)(kp);      kf[1]=*(const __attribute__((address_space(3))) bf16x8*)(kp+512);
  kf[2]=*(const __attribute__((address_space(3))) bf16x8*)(kp+2048); kf[3]=*(const __attribute__((address_space(3))) bf16x8*)(kp+2560);
  kf[4]=*(const __attribute__((address_space(3))) bf16x8*)(kp+4096); kf[5]=*(const __attribute__((address_space(3))) bf16x8*)(kp+4608);
  kf[6]=*(const __attribute__((address_space(3))) bf16x8*)(kp+6144); kf[7]=*(const __attribute__((address_space(3))) bf16x8*)(kp+6656);
}
__device__ __forceinline__ void kload2(bf16x8*kf,lds_cptr kp,int j){ kf[2*j]=*(const __attribute__((address_space(3))) bf16x8*)(kp+j*2048); kf[2*j+1]=*(const __attribute__((address_space(3))) bf16x8*)(kp+j*2048+512); }
__device__ __forceinline__ s16x4 vtr(lds_cptr p){ return __builtin_bit_cast(s16x4,__builtin_amdgcn_ds_read_tr16_b64_v4i16((__attribute__((address_space(3))) v4i16_t*)p)); }
__device__ __forceinline__ float rowmax(const f32x16&p0,const f32x16&p1){
  float a=max3f(p0[0],p0[1],p1[0]),b=max3f(p0[2],p0[3],p1[1]);a=max3f(a,p1[2],p1[3]);
  #pragma unroll
  for(int r=4;r<16;r+=4){a=max3f(a,p0[r],p0[r+1]);b=max3f(b,p0[r+2],p0[r+3]);a=max3f(a,p1[r],p1[r+1]);b=max3f(b,p1[r+2],p1[r+3]);}
  const float m=max2f(a,b);
  auto rr=__builtin_amdgcn_permlane32_swap(__float_as_uint(m),__float_as_uint(m),false,false);
  return max2f(__uint_as_float(rr[0]),__uint_as_float(rr[1]));
}
__device__ __forceinline__ void pv(f32x16*o,int vb,bf16x8 pa0,bf16x8 pa1,bf16x8 pa2,bf16x8 pa3){
  #pragma unroll
  for(int d0=0;d0<2;++d0){s16x4 lo[4],hi[4];
    #pragma unroll
    for(int ks=0;ks<4;++ks){
      asm volatile("ds_read_b64_tr_b16 %0,%1 offset:%c2":"=&v"(lo[ks]):"v"(vb),"i"(d0*4096+ks*1024):"memory");
      asm volatile("ds_read_b64_tr_b16 %0,%1 offset:%c2":"=&v"(hi[ks]):"v"(vb),"i"(d0*4096+ks*1024+512):"memory");}
    asm volatile("s_waitcnt lgkmcnt(0)":::"memory");SBAR();
    #define PK(k) (bf16x8){lo[k][0],lo[k][1],lo[k][2],lo[k][3],hi[k][0],hi[k][1],hi[k][2],hi[k][3]}
    o[d0]=__builtin_amdgcn_mfma_f32_32x32x16_bf16(pa0,PK(0),o[d0],0,0,0);
    o[d0]=__builtin_amdgcn_mfma_f32_32x32x16_bf16(pa1,PK(1),o[d0],0,0,0);
    o[d0]=__builtin_amdgcn_mfma_f32_32x32x16_bf16(pa2,PK(2),o[d0],0,0,0);
    o[d0]=__builtin_amdgcn_mfma_f32_32x32x16_bf16(pa3,PK(3),o[d0],0,0,0);
    #undef PK
  }
}

#ifndef ATTN_STORE16
#define ATTN_STORE16(p,v) (*(u32x4*)(p)=(v))
#endif
template<int THRL,int QP,int OP,bool NA> __device__ __forceinline__ void attn_unit(const bf16*Qu,const bf16*__restrict__ Kh,const bf16*__restrict__ Vh,bf16*Ou,const int NT,char*shm,const int klo,const int r0,const float*rpbh,const int wid){
  const int lane=lane_id(),tid=wid*64+lane,r32=lane&31,hi=lane>>5;
  const bf16*Qw=Qu+(long)(wid*QBLK)*QP;
  const unsigned lds0=(unsigned)(uintptr_t)shm;
  float*wsf=(float*)(shm+LDS_WS)+wid*64;
  const bf16*ksrc=Kh+(long)lane*QP+wid*8;
  const bf16*vsrc=Vh+(long)(16*(wid&3)+(lane>>2))*QP+(wid>>2)*32+(lane&3)*8;
  const unsigned kdst=lds0+LDS_K+wid*1024, vdst=lds0+LDS_V+wid*1024;
  #define TBLK(t) (NA?((t)<4?(t):(t)+klo):(t))
  #define DMA_K(t,slot) glds16(ksrc+(long)TBLK(t)*KVBLK*QP,(unsigned)__builtin_amdgcn_readfirstlane(kdst+(slot)))
  #define DMA_V(t,slot) glds16(vsrc+(long)TBLK(t)*KVBLK*QP,(unsigned)__builtin_amdgcn_readfirstlane(vdst+(slot)))
  const int vb0=(int)(lds0+LDS_V)+((lane>>4)&1)*32+(lane&3)*8+(4*hi+((lane&15)>>2))*64;
  const char*Kbase=shm+LDS_K; bf16x8 kf[8];
  const lds_cptr shm3=(lds_cptr)shm; const lds_cptr kp0=shm3+LDS_K+hi*1024+r32*16; const lds_cptr vp0=shm3+LDS_V+((lane>>4)&1)*32+(lane&3)*8+(4*hi+((lane&15)>>2))*64;
  DMA_K(0,0);DMA_V(0,0);DMA_K(1,SLOTB);
  bf16x8 qr[4];
  #pragma unroll
  for(int d0=0;d0<4;++d0)qr[d0]=*reinterpret_cast<const bf16x8*>(&Qw[(long)r32*QP+d0*16+hi*8]);
  float mhat=0.f,l_reg=0.f;f32x16 o[2];o[0]=f32x16{};o[1]=f32x16{};asm volatile("":"+v"(o[0]),"+v"(o[1]));f32x16 negm=f32x16{};asm volatile("":"+v"(negm));
  const int rq=r0+(wid>>1), rsq=min(max(rq-4,0),24), qcol=32*(wid&1)+r32, cs=min(max(qcol-8,0),48);
  typedef __attribute__((address_space(3))) const float* lds_fptr;
  const lds_fptr tblf=(lds_fptr)((__attribute__((address_space(3))) const char*)shm+TBL_OFF);
  const lds_fptr tbl_lane=tblf+(qcol<8?NAT_TE+qcol*NAT_TEP+4*hi:(qcol>56?NAT_TE+(qcol-56)*NAT_TEP+16+4*hi:NAT_TI+4*hi-qcol+15+44));
  const int tbl_pitch=(qcol<8||qcol>56)?NAT_TES:NAT_TIW;
  const lds_fptr zrow=tblf+NAT_Z+4*hi, nirow=tblf+NAT_NI+4*hi;
  lds_fptr tpn_=zrow; float bt_[2][4];
  #define BIA_PTR(tn) do{ if(NA){ const int krow_=klo+(tn)-4; const bool loc_=(tn)>=4, rel_=loc_&&krow_>=rsq&&krow_<rsq+8; tpn_=rel_?tbl_lane+(krow_-rq+7)*tbl_pitch:(loc_?nirow:zrow); } }while(0)
  #define BIA_RD(i) do{ if(NA){ const int kr_=((2*(i))&3)+8*((2*(i))>>2); bt_[(i)&1][0]=tpn_[kr_]; bt_[(i)&1][1]=tpn_[kr_+1]; bt_[(i)&1][2]=tpn_[kr_+32]; bt_[(i)&1][3]=tpn_[kr_+33]; } }while(0)
  #define BIA_ADD(Q0,Q1,i) do{ if(NA){ const float nm_=negm[0]; Q0[2*(i)]=bt_[(i)&1][0]+nm_; Q0[2*(i)+1]=bt_[(i)&1][1]+nm_; Q1[2*(i)]=bt_[(i)&1][2]+nm_; Q1[2*(i)+1]=bt_[(i)&1][3]+nm_; } }while(0)
  bool resc=false;
  #define START(P0,P1) do{ const float rm=rowmax(P0,P1); resc=false; \
    { const float dl=rm; mhat=fadd_s(mhat,dl); \
      _Pragma("unroll") for(int r=0;r<16;++r){P0[r]=fsub_s(P0[r],dl);P1[r]=fsub_s(P1[r],dl);} \
      _Pragma("unroll") for(int r=0;r<16;++r)negm[r]=-mhat; asm volatile("":"+v"(negm)); } \
    _Pragma("unroll") for(int r=0;r<16;++r)P0[r]=__builtin_amdgcn_exp2f(P0[r]); }while(0)
  #define RESC() do{ if(resc){ asm volatile("s_waitcnt lgkmcnt(0)":::"memory"); \
      _Pragma("unroll") for(int d_=0;d_<2;++d_) _Pragma("unroll") for(int r=0;r<16;++r)o[d_][r]*=wsf[crow(r,hi)]; } }while(0)
  f32x16 pA0,pA1,pB0,pB1;
  int sl_prev=0,sl_cur=0,sl_next=SLOTB;
  #define ROT() do{sl_prev=sl_cur;sl_cur=sl_next;sl_next=(sl_next==(NSLOT-1)*SLOTB)?0:sl_next+SLOTB;}while(0)
  DMA_K(2,2*SLOTB);
  WAIT_BAR(3);
  qkt(pA0,pA1,Kbase,qr,negm,r32,hi);asm volatile("s_nop 15\n\ts_nop 7":"+v"(pA0),"+v"(pA1));
  START(pA0,pA1);
  _Pragma("unroll") for(int r=0;r<16;++r)pA1[r]=__builtin_amdgcn_exp2f(pA1[r]);
  if(NA){ _Pragma("unroll") for(int r=0;r<16;++r){pB0[r]=negm[0];pB1[r]=negm[0];} }
  WAIT_BAR(0);
  DMA_K(3,0);DMA_V(1,SLOTB);
  ROT();
  kload8(kf,kp0+sl_cur);
  WAIT_BAR(2);
  s16x4 vlo[8],vhi[8]; u32x4 pw0,pw1,pw2,pw3;
  #define PKW(P,B) cvtpk_s(P[B],P[B+1])
  #define PAF(k) __builtin_bit_cast(bf16x8,pw##k)
  #define VFR(i) (bf16x8){vlo[i][0],vlo[i][1],vlo[i][2],vlo[i][3],vhi[i][0],vhi[i][1],vhi[i][2],vhi[i][3]}
  #define PIN(x) asm volatile("":"+v"(x))
  #define MX3(a,b,c) __builtin_fmaxf(__builtin_fmaxf((a),(b)),(c))
  #define GAPA(MF,A0,A1,A2,A3,W0,W1,PW) do{ MF; sacc+=A0; sacc+=A1; sacc+=A2; sacc+=A3; PIN(sacc); W0; W1; PIN(PW); SBAR(); }while(0)
  #define EX(v) __builtin_amdgcn_exp2f(v)
  #define GAPB(MF,X,B) do{ MF; X[B]=EX(X[B]); X[B+1]=EX(X[B+1]); X[B+2]=EX(X[B+2]); X[B+3]=EX(X[B+3]); PIN(X); SBAR(); }while(0)
  #define VRD(i) do{ vlo[i]=vtr(vp_+(((i)>>2)*4096+((i)&3)*1024)); vhi[i]=vtr(vp_+(((i)>>2)*4096+((i)&3)*1024+512)); }while(0)
  #define KRD(G,j) do{ if(G){ kload2(kf,kp0+sl_next,j); SBAR(); } }while(0)
  #define STEP(C0,C1,P0,P1,t,GK,GV,GL) do{ SBAR(); \
    const lds_cptr vp_=vp0+sl_prev; \
    VRD(0); SBAR(); float sacc=(P0[0]+P0[1]); \
    GAPA(C0=__builtin_amdgcn_mfma_f32_32x32x16_bf16(kf[0],qr[0],NA?C0:negm,0,0,0), P0[2],P0[3],P0[4],P0[5],     pw0[0]=PKW(P0,0), pw0[1]=PKW(P0,2), pw0); \
    VRD(4); SBAR(); GAPA(C1=__builtin_amdgcn_mfma_f32_32x32x16_bf16(kf[1],qr[0],NA?C1:negm,0,0,0), P0[6],P0[7],P0[8],P0[9],     pw0[2]=PKW(P0,4), pw0[3]=PKW(P0,6), pw0); \
    VRD(1); SBAR(); GAPA(C0=__builtin_amdgcn_mfma_f32_32x32x16_bf16(kf[2],qr[1],C0,0,0,0),   P0[10],P0[11],P0[12],P0[13], pw1[0]=PKW(P0,8), pw1[1]=PKW(P0,10), pw1); \
    VRD(5); SBAR(); GAPA(C1=__builtin_amdgcn_mfma_f32_32x32x16_bf16(kf[3],qr[1],C1,0,0,0),   P0[14],P0[15],P1[0],P1[1],   pw1[2]=PKW(P0,12),pw1[3]=PKW(P0,14), pw1); \
    VRD(2); SBAR(); GAPA(C0=__builtin_amdgcn_mfma_f32_32x32x16_bf16(kf[4],qr[2],C0,0,0,0),   P1[2],P1[3],P1[4],P1[5],     pw2[0]=PKW(P1,0), pw2[1]=PKW(P1,2), pw2); \
    VRD(6); SBAR(); GAPA(C1=__builtin_amdgcn_mfma_f32_32x32x16_bf16(kf[5],qr[2],C1,0,0,0),   P1[6],P1[7],P1[8],P1[9],     pw2[2]=PKW(P1,4), pw2[3]=PKW(P1,6), pw2); \
    VRD(3); SBAR(); GAPA(C0=__builtin_amdgcn_mfma_f32_32x32x16_bf16(kf[6],qr[3],C0,0,0,0),   P1[10],P1[11],P1[12],P1[13], pw3[0]=PKW(P1,8), pw3[1]=PKW(P1,10), pw3); \
    VRD(7); SBAR(); GAPA(C1=__builtin_amdgcn_mfma_f32_32x32x16_bf16(kf[7],qr[3],C1,0,0,0),   P1[14],P1[15],0.f,0.f,       pw3[2]=PKW(P1,12),pw3[3]=PKW(P1,14), pw3); \
    l_reg+=sacc; \
    if(GK){DMA_K((t)+3,sl_cur);} if(GV){DMA_V((t)+1,sl_next);} \
    BIA_PTR((t)+1); \
    { float a=MX3(C0[0],C0[1],C1[0]),b=MX3(C0[2],C0[3],C1[1]); a=MX3(a,C1[2],C1[3]); \
      _Pragma("unroll") for(int r=4;r<16;r+=4){a=MX3(a,C0[r],C0[r+1]);b=MX3(b,C0[r+2],C0[r+3]);a=MX3(a,C1[r],C1[r+1]);b=MX3(b,C1[r+2],C1[r+3]);} \
      float rm=__builtin_fmaxf(a,b); { auto rr=__builtin_amdgcn_permlane32_swap(__float_as_uint(rm),__float_as_uint(rm),false,false); rm=__builtin_fmaxf(__uint_as_float(rr[0]),__uint_as_float(rr[1])); } \
      resc=false; \
      if(__builtin_expect(__any(rm>(float)THRL),0)){ const float dl=__builtin_fmaxf(rm,0.f); mhat+=dl; \
        _Pragma("unroll") for(int r=0;r<16;++r){C0[r]-=dl;C1[r]-=dl;} \
        _Pragma("unroll") for(int r=0;r<16;++r)negm[r]=-mhat; asm volatile("":"+v"(negm)); \
        const float f=__builtin_amdgcn_exp2f(-dl); l_reg*=f; if(hi==0)wsf[r32]=f; resc=true; } } \
    SBAR(); \
    BIA_RD(0); GAPB(o[0]=__builtin_amdgcn_mfma_f32_32x32x16_bf16(PAF(0),VFR(0),o[0],0,0,0), C0,0); \
    BIA_RD(1); BIA_ADD(P0,P1,0); GAPB(o[1]=__builtin_amdgcn_mfma_f32_32x32x16_bf16(PAF(0),VFR(4),o[1],0,0,0), C0,4); \
    KRD(GL,0); BIA_RD(2); BIA_ADD(P0,P1,1); GAPB(o[0]=__builtin_amdgcn_mfma_f32_32x32x16_bf16(PAF(1),VFR(1),o[0],0,0,0), C0,8); \
    KRD(GL,1); BIA_RD(3); BIA_ADD(P0,P1,2); GAPB(o[1]=__builtin_amdgcn_mfma_f32_32x32x16_bf16(PAF(1),VFR(5),o[1],0,0,0), C0,12); \
    KRD(GL,2); BIA_RD(4); BIA_ADD(P0,P1,3); GAPB(o[0]=__builtin_amdgcn_mfma_f32_32x32x16_bf16(PAF(2),VFR(2),o[0],0,0,0), C1,0); \
    KRD(GL,3); BIA_RD(5); BIA_ADD(P0,P1,4); GAPB(o[1]=__builtin_amdgcn_mfma_f32_32x32x16_bf16(PAF(2),VFR(6),o[1],0,0,0), C1,4); \
    BIA_RD(6); BIA_ADD(P0,P1,5); GAPB(o[0]=__builtin_amdgcn_mfma_f32_32x32x16_bf16(PAF(3),VFR(3),o[0],0,0,0), C1,8); \
    BIA_RD(7); BIA_ADD(P0,P1,6); GAPB(o[1]=__builtin_amdgcn_mfma_f32_32x32x16_bf16(PAF(3),VFR(7),o[1],0,0,0), C1,12); \
    BIA_ADD(P0,P1,7); \
    }while(0)
  int t=1;
  for(;t+5<NT;t+=2){
    STEP(pB0,pB1,pA0,pA1,t,true,true,true);     WAIT_BAR(2); RESC(); ROT();
    STEP(pA0,pA1,pB0,pB1,t+1,true,true,true);   WAIT_BAR(2); RESC(); ROT();
  }
  #define ENDW(tt) do{ if((tt)+3<NT){WAIT_BAR(2);} else if((tt)+2<NT){WAIT_BAR(1);} else {WAIT_BAR(0);} }while(0)
  for(;t+1<NT;t+=2){
    STEP(pB0,pB1,pA0,pA1,t,(t+3<NT),(t+1<NT),(t+1<NT));       ENDW(t);   RESC(); ROT();
    STEP(pA0,pA1,pB0,pB1,t+1,(t+4<NT),(t+2<NT),(t+2<NT));     ENDW(t+1); RESC(); ROT();
  }
  STEP(pB0,pB1,pA0,pA1,NT-1,false,false,false); RESC();
  { float sacc=pB0[0]+pB0[1]; _Pragma("unroll") for(int r=2;r<16;++r)sacc+=pB0[r]; _Pragma("unroll") for(int r=0;r<16;++r)sacc+=pB1[r]; l_reg+=sacc;
    pw0=(u32x4){PKW(pB0,0),PKW(pB0,2),PKW(pB0,4),PKW(pB0,6)};pw1=(u32x4){PKW(pB0,8),PKW(pB0,10),PKW(pB0,12),PKW(pB0,14)};pw2=(u32x4){PKW(pB1,0),PKW(pB1,2),PKW(pB1,4),PKW(pB1,6)};pw3=(u32x4){PKW(pB1,8),PKW(pB1,10),PKW(pB1,12),PKW(pB1,14)};
    SBAR(); pv(o,vb0+sl_cur,PAF(0),PAF(1),PAF(2),PAF(3)); }
  #undef PKW
  #undef PAF
  #undef VFR
  #undef PIN
  #undef MX3
  #undef GAPA
  #undef GAPB
  #undef EX
  #undef VRD
  #undef KRD
  #undef STEP
  #undef ENDW
  {auto rr=__builtin_amdgcn_permlane32_swap(__float_as_uint(l_reg),__float_as_uint(l_reg),false,false);l_reg=__uint_as_float(rr[0])+__uint_as_float(rr[1]);}
  if(hi==0)wsf[32+r32]=l_reg;asm volatile("s_waitcnt lgkmcnt(0)":::"memory");
  float rli[16];
  #pragma unroll
  for(int r=0;r<16;++r)rli[r]=__builtin_amdgcn_rcpf(wsf[32+crow(r,hi)]);
  bf16*Ow=Ou+(long)(wid*QBLK)*OP;
  { bf16*stg=(bf16*)(shm+LDS_OST)+wid*2048;
    #pragma unroll
    for(int r=0;r<16;++r){const int orow=crow(r,hi);
      #pragma unroll
      for(int d0=0;d0<2;++d0)stg[orow*64+d0*32+r32]=__float2bfloat16(o[d0][r]*rli[r]);}
    asm volatile("s_waitcnt lgkmcnt(0)":::"memory");
    #pragma unroll
    for(int i=0;i<4;++i){const int row=i*8+(lane>>3),ch=lane&7; const u32x4 v=*(const u32x4*)(stg+row*64+ch*8); ATTN_STORE16(Ow+(long)row*OP+ch*8,v);} }
  asm volatile("s_waitcnt lgkmcnt(0)\n\ts_barrier":::"memory");
  #undef DMA_K
  #undef TBLK
  #undef DMA_V
  #undef BIA_PTR
  #undef BIA_RD
  #undef BIA_ADD
  #undef START
  #undef RESC
  #undef ROT
}
constexpr int ATTN_LDS_BYTES=LDS_BYTES;
#undef SBAR
#undef WAIT_BAR
}
constexpr int NWAVES = 8, NTHR = 512;
constexpr int DM = 1024, NB = 16, SEQ = 2048, NCTX = 256, TOT = SEQ + NCTX;
constexpr int MROWS = NB * TOT;
constexpr int NLAT = NB * SEQ;
constexpr int GRIDW = 64;
constexpr int ABW = 2336, ABP = 2560;
constexpr int DFF = 3584, NEXP = 8;
constexpr int QKVW = 3072;
constexpr float EPS = 1e-6f;
constexpr float LOG2E = 1.4426950408889634f;
constexpr float C2 = 0.125f * LOG2E;
constexpr int PA_Q = 0, PA_K = 512, PA_V = 640, PB_Q = 768, PB_K = 1024, PB_V = 1280, PB_R = 1792, PZ_F = 2304, PZ_B = 2320;
constexpr int MOE_CHUNK = 128, MOE_NCHUNK = 3, MOE_MAXT = 264;

constexpr size_t MiB = 1u << 20;
constexpr size_t WS_CTL = 0, CTL_ZERO_BYTES = 1 * MiB;
constexpr size_t WS_MOD = 1 * MiB;
constexpr size_t WS_RE = 2 * MiB;
constexpr size_t WS_RG = WS_RE + 256 * 1024;
constexpr size_t WS_SLOT = WS_RG + 256 * 1024;
constexpr size_t WS_ROWIDX = WS_SLOT + 256 * 1024;
constexpr size_t WS_CNT = WS_ROWIDX + 512 * 1024;
constexpr size_t WS_TB = WS_CNT + 16 * 1024;
constexpr size_t WS_CTXS = 4 * MiB;
constexpr size_t WS_WINAB = 20 * MiB, WS_WOUTAB = 25 * MiB, WS_WFF1 = 27 * MiB, WS_WFF2 = 41 * MiB, WS_WINC = 48 * MiB, WS_WOUTC = 54 * MiB, WS_WMOE1 = 56 * MiB, WS_WMOE2 = 168 * MiB;
constexpr size_t WS_A = 224 * MiB;
constexpr size_t WS_XL = WS_A, WS_XC = WS_A + 64 * MiB;
constexpr size_t WS_B = 296 * MiB;
constexpr size_t WS_PROJ0 = WS_B, WS_GLAF = WS_B + 180 * MiB, WS_GLAR = WS_B + 216 * MiB;
constexpr size_t WS_ACT = WS_B, WS_QKV = WS_B;
constexpr size_t WS_ACTC = WS_B;
constexpr size_t WS_YA = WS_B + 224 * MiB;
constexpr size_t WS_YB = WS_WMOE1;
constexpr size_t WS_PART = 4 * MiB;
constexpr size_t WS_PARTC = WS_B + 252 * MiB;
constexpr size_t WS_END = WS_PARTC + 48 * MiB;
static_assert(WS_YA + (size_t)32768 * 1024 * 2 <= WS_END && WS_ACTC + (size_t)MOE_CHUNK * 256 * 3584 * 2 <= WS_YA && WS_PART + 32 * MiB <= WS_WFF2 && MOE_CHUNK * 2 * 256 == 65536, "ws map");
constexpr int CW_TMO = 0, CW_BAR = 4096;

constexpr int RING_BYTES = 131072, LDSCTL_OFF = RING_BYTES, MISC_OFF = LDSCTL_OFF + 320, LDS_BYTES = 147456;

#define GAS __attribute__((address_space(1)))
#define LAS __attribute__((address_space(3)))
typedef unsigned short bf16;
typedef unsigned v4u __attribute__((ext_vector_type(4)));
typedef unsigned v2u __attribute__((ext_vector_type(2)));
typedef float f32x4 __attribute__((ext_vector_type(4)));
typedef float f32x2 __attribute__((ext_vector_type(2)));
typedef GAS unsigned gu32;
#define RLX_AGENT __ATOMIC_RELAXED, __HIP_MEMORY_SCOPE_AGENT
#define LDS_WAIT() asm volatile("s_waitcnt lgkmcnt(0)" ::: "memory")
#define LDS_BARRIER() asm volatile("s_waitcnt lgkmcnt(0)\n\ts_barrier" ::: "memory")
__device__ __forceinline__ unsigned f2bf(float f) { unsigned u = __builtin_bit_cast(unsigned, f); return (u + 0x7fffu + ((u >> 16) & 1u)) >> 16; }
__device__ __forceinline__ unsigned pk2(float lo, float hi) { return f2bf(lo) | (f2bf(hi) << 16); }
__device__ __forceinline__ float bf2f(unsigned short h) { return __builtin_bit_cast(float, (unsigned)h << 16); }
__device__ __forceinline__ float bflo(unsigned w) { return __builtin_bit_cast(float, w << 16); }
__device__ __forceinline__ float bfhi(unsigned w) { return __builtin_bit_cast(float, w & 0xffff0000u); }
__device__ __forceinline__ float fexp2(float x) { return __builtin_amdgcn_exp2f(x); }
__device__ __forceinline__ float frcp(float x) { return __builtin_amdgcn_rcpf(x); }
__device__ __forceinline__ float silu_f(float x) { return x * frcp(1.f + fexp2(-x * LOG2E)); }
__device__ __forceinline__ float wave_sum(float v) {
#pragma unroll
    for (int o = 1; o < 64; o <<= 1) v += __shfl_xor(v, o);
    return v;
}

#define XB_TMO      128
#define XB_XCNT(j)  (256  + 64 * (j))
#define XB_XSUB(j)  (1280 + 64 * (j))
#define XB_XGEN(j)  (2304 + 64 * (j))
#define XB_TOP      3328
#define XB_TOPGEN   3392
#define XCD_BAR_WORDS 3456
#define XB_SPIN_CAP (1u << 22)
__device__ __forceinline__ unsigned xb_ld(unsigned* p)              { return __hip_atomic_load(p, __ATOMIC_RELAXED, __HIP_MEMORY_SCOPE_AGENT); }
__device__ __forceinline__ unsigned xb_add(unsigned* p, unsigned v) { return __hip_atomic_fetch_add(p, v, __ATOMIC_RELAXED, __HIP_MEMORY_SCOPE_AGENT); }
__device__ __forceinline__ unsigned xb_xcc_id() { return (unsigned)__builtin_amdgcn_s_getreg((3 << 11) | 20) & 0xFu; }
#define XB_SPIN(cond, bar) do { unsigned _sp = 0; while (cond) { __builtin_amdgcn_s_sleep(1); \
    if ((++_sp & 255u) == 0u) { if (xb_ld(&(bar)[XB_TMO])) break; if (_sp > XB_SPIN_CAP) { atomicAdd(&(bar)[XB_TMO], 1u); break; } } } } while (0)
struct XcdBarrier { unsigned* bar; unsigned x; volatile LAS unsigned* st; };
__device__ __forceinline__ XcdBarrier xcd_barrier_post(unsigned* bar, volatile LAS unsigned* st) {
    XcdBarrier b; b.bar = bar; b.x = xb_xcc_id(); b.st = st;
    if (threadIdx.x == 0) (void)xb_add(&bar[XB_XCNT(b.x)], 1u);
    return b;
}
__device__ __forceinline__ void xcd_barrier_complete(unsigned* bar, unsigned x, unsigned& nloc, unsigned& nx) {
    const unsigned G = gridDim.x * gridDim.y * gridDim.z;
    unsigned sum, cnt, mine, sp = 0u;
    for (;;) {
        sum = 0u; cnt = 0u; mine = 0u;
#pragma unroll
        for (unsigned j = 0; j < 16; ++j) { const unsigned c = xb_ld(&bar[XB_XCNT(j)]); sum += c; cnt += (c > 0u) ? 1u : 0u; mine = (j == x) ? c : mine; }
        if (sum == G) break;
        __builtin_amdgcn_s_sleep(1);
        if ((++sp & 255u) == 0u) { if (xb_ld(&bar[XB_TMO])) break; if (sp > XB_SPIN_CAP) { atomicAdd(&bar[XB_TMO], 1u); break; } }
    }
    nloc = mine > 0u ? mine : 1u; nx = cnt > 0u ? cnt : 1u;
}
__device__ __forceinline__ void xcd_barrier(const XcdBarrier& b) {
    asm volatile("s_waitcnt vmcnt(0)" ::: "memory");
    __syncthreads();
    if (threadIdx.x == 0) {
        unsigned* bar = b.bar;
        __builtin_amdgcn_s_waitcnt(0);
        unsigned nloc = b.st[0], nx = b.st[1];
        if (nloc == 0u) { xcd_barrier_complete(bar, b.x, nloc, nx); b.st[0] = nloc; b.st[1] = nx; }
        const unsigned old = xb_add(&bar[XB_XSUB(b.x)], 1u);
        const unsigned gen = old / nloc;
        if (old + 1u == (gen + 1u) * nloc) {
            __builtin_amdgcn_fence(__ATOMIC_RELEASE, "agent");
            asm volatile("s_waitcnt vmcnt(0)" ::: "memory");
            const unsigned og = xb_add(&bar[XB_TOP], 1u);
            const unsigned tg = og / nx;
            if (og + 1u == (tg + 1u) * nx) xb_add(&bar[XB_TOPGEN], 1u);
            else XB_SPIN(xb_ld(&bar[XB_TOPGEN]) == tg, bar);
            __builtin_amdgcn_fence(__ATOMIC_ACQUIRE, "agent");
            xb_add(&bar[XB_XGEN(b.x)], 1u);
            asm volatile("s_waitcnt vmcnt(0)" ::: "memory");
        } else {
            XB_SPIN(xb_ld(&bar[XB_XGEN(b.x)]) == gen, bar);
            __builtin_amdgcn_fence(__ATOMIC_ACQUIRE, "agent");
            asm volatile("s_waitcnt vmcnt(0)" ::: "memory");
        }
    }
    __syncthreads();
}

struct Args { const float* in[28]; float* out; unsigned char* ws; int ph_lo, ph_hi; };
enum { I_X = 0, I_C, I_CTX, I_CCTX, I_WMOD, I_BMOD, I_GN1, I_GN2, I_WINAB, I_GQ, I_GK, I_WA2F, I_BAF, I_WA2B, I_BAB, I_GGLA, I_WOUTAB, I_WFFG, I_WFFU, I_WFFD, I_WINC, I_RPB, I_WOUTC, I_WROUTER, I_WMG, I_WMU, I_WMD, I_GFINAL };

struct Frame {
    LAS unsigned char* lds;
    int wave, vcu, G;
};

__device__ __forceinline__ const float* srow(const float* lat, const float* ctx, int r) {
    const int b = r / TOT, t = r - b * TOT;
    return t < NCTX ? ctx + (size_t)(b * NCTX + t) * DM : lat + (size_t)(b * SEQ + t - NCTX) * DM;
}

struct SchedAll {
    pg8::Deal D; unsigned rowbytes;
    __device__ __forceinline__ bool next(int i, pg8::Unit& u) const { int lm, j; if (!D.get(i, lm, j)) return false; u.pm = lm; u.pn = j; u.pc = j; u.po = lm; u.kb = 0; return true; }
    __device__ __forceinline__ unsigned arow(const pg8::Unit& u, int r) const { return (unsigned)(u.pm * 256 + r) * rowbytes; }
};
struct SchedLat {
    pg8::Deal D; unsigned rowbytes;
    __device__ __forceinline__ bool next(int i, pg8::Unit& u) const { int lm, j; if (!D.get(i, lm, j)) return false; u.pm = (lm >> 3) * 9 + 1 + (lm & 7); u.pn = j; u.pc = j; u.po = u.pm; u.kb = 0; return true; }
    __device__ __forceinline__ unsigned arow(const pg8::Unit& u, int r) const { return (unsigned)(u.pm * 256 + r) * rowbytes; }
};
struct SchedMoe1 {
    pg8::Deal D; int m0; int tb[8]; const int* rowidx;
    __device__ __forceinline__ int expert(int pm) const { int e = 0;
#pragma unroll
        for (int k = 1; k < 8; ++k) e += (pm >= tb[k]) ? 1 : 0;
        return e; }
    __device__ __forceinline__ bool next(int i, pg8::Unit& u) const { int lm, j; if (!D.get(i, lm, j)) return false; u.pm = m0 + lm; u.pn = expert(u.pm) * 28 + j; u.pc = j; u.po = lm; u.kb = 0; return true; }
    __device__ __forceinline__ unsigned arow(const pg8::Unit& u, int r) const {
        typedef int i32x16 __attribute__((ext_vector_type(16)));
        const int* p = rowidx + u.pm * 256 + __builtin_amdgcn_readfirstlane(r & ~15);
        i32x16 v; asm volatile("s_load_dwordx16 %0, %1, 0x0\n\ts_waitcnt lgkmcnt(0)" : "=s"(v) : "s"(p) : "memory");
        const int sel = r & 15; int x = v[0];
#pragma unroll
        for (int i = 1; i < 16; ++i) x = (sel == i) ? v[i] : x;
        return (unsigned)x * (unsigned)(DM * 2); }
};
struct SchedMoe2 {
    pg8::Deal D; int m0; int tb[8];
    __device__ __forceinline__ int expert(int pm) const { int e = 0;
#pragma unroll
        for (int k = 1; k < 8; ++k) e += (pm >= tb[k]) ? 1 : 0;
        return e; }
    __device__ __forceinline__ bool next(int i, pg8::Unit& u) const { int lm, j; if (!D.get(i, lm, j)) return false; u.pm = lm; u.pn = expert(m0 + lm) * 4 + j; u.pc = j; u.po = m0 + lm; u.kb = 0; return true; }
    __device__ __forceinline__ unsigned arow(const pg8::Unit& u, int r) const { return (unsigned)(u.pm * 256 + r) * (unsigned)(DFF * 2); }
};

struct SchedMoe2Split {
    int G, c, nT, m0; int tb[8];
    __device__ __forceinline__ int expert(int pm) const { int e = 0;
#pragma unroll
        for (int k = 1; k < 8; ++k) e += (pm >= tb[k]) ? 1 : 0;
        return e; }
    __device__ __forceinline__ bool next(int i, pg8::Unit& u) const { const int L = i * G + c; if (L >= nT * 16) return false;
        const int lm = L >> 4, j = (L >> 2) & 3, ks = L & 3; u.pm = lm; u.pn = expert(m0 + lm) * 4 + j; u.pc = j + 4 * ks; u.po = lm; u.kb = ks * (DFF / 4) * 2; return true; }
    __device__ __forceinline__ unsigned arow(const pg8::Unit& u, int r) const { return (unsigned)(u.pm * 256 + r) * (unsigned)(DFF * 2) + (unsigned)u.kb; }
};

struct SchedCtxSplit {
    int G, c, ksub; unsigned rowbytes;
    __device__ __forceinline__ bool next(int i, pg8::Unit& u) const { const int L = i * G + c; if (L >= 16 * 16) return false;
        const int lm = L >> 4, j = (L >> 2) & 3, ks = L & 3; u.pm = lm * 9; u.pn = j; u.pc = j + 4 * ks; u.po = u.pm; u.kb = ks * ksub * 2; return true; }
    __device__ __forceinline__ unsigned arow(const pg8::Unit& u, int r) const { return (unsigned)(u.pm * 256 + r) * rowbytes + (unsigned)u.kb; }
};

struct EpiBf16 {
    pg8::bf16_t* O; int ldc; int nscale; float scale;
    __device__ __forceinline__ void operator()(const pg8::f32x4 (&acc)[2][2][4][2], const pg8::Unit& u, int wr, int wc) const {
        const int lane_ = lane_id(), fr = lane_ & 15, fq = lane_ >> 4;
        const int row0 = u.po * 256 + wr * 64 + fr, col0 = u.pc * 256 + wc * 32 + 8 * fq;
        const float sc = (u.pc < nscale) ? scale : 1.f;
#pragma unroll
        for (int ai = 0; ai < 2; ++ai)
#pragma unroll
            for (int m = 0; m < 4; ++m) { pg8::bf16_t* rowp = O + (size_t)(row0 + ai * 128 + m * 16) * ldc + col0;
#pragma unroll
                for (int bj = 0; bj < 2; ++bj) { const pg8::f32x4 v0 = acc[ai][bj][m][0] * sc, v1 = acc[ai][bj][m][1] * sc;
                    pg8::u32x4 w; w.x = pg8::cvt_pk_bf16(v0[0], v0[1]); w.y = pg8::cvt_pk_bf16(v0[2], v0[3]); w.z = pg8::cvt_pk_bf16(v1[0], v1[1]); w.w = pg8::cvt_pk_bf16(v1[2], v1[3]);
                    *(pg8::u32x4*)(rowp + bj * 128) = w; } }
    }
};
struct EpiSwiglu {
    pg8::bf16_t* O; int ldc;
    __device__ __forceinline__ void operator()(const pg8::f32x4 (&acc)[2][2][4][2], const pg8::Unit& u, int wr, int wc) const {
        const int lane_ = lane_id(), fr = lane_ & 15, fq = lane_ >> 4;
        const int row0 = u.po * 256 + wr * 64 + fr, col0 = u.pc * 128 + wc * 32 + 8 * fq;
#pragma unroll
        for (int ai = 0; ai < 2; ++ai)
#pragma unroll
            for (int m = 0; m < 4; ++m) { pg8::bf16_t* rowp = O + (size_t)(row0 + ai * 128 + m * 16) * ldc + col0;
                float a[8];
#pragma unroll
                for (int n = 0; n < 2; ++n)
#pragma unroll
                    for (int e = 0; e < 4; ++e) a[n * 4 + e] = silu_f(acc[ai][0][m][n][e]) * acc[ai][1][m][n][e];
                pg8::u32x4 w; w.x = pg8::cvt_pk_bf16(a[0], a[1]); w.y = pg8::cvt_pk_bf16(a[2], a[3]); w.z = pg8::cvt_pk_bf16(a[4], a[5]); w.w = pg8::cvt_pk_bf16(a[6], a[7]);
                *(pg8::u32x4*)rowp = w; }
    }
};
__device__ __forceinline__ pg8::f32x4 bf4lo(unsigned a, unsigned b) { return (pg8::f32x4){__builtin_bit_cast(float, a << 16), __builtin_bit_cast(float, a & 0xffff0000u), __builtin_bit_cast(float, b << 16), __builtin_bit_cast(float, b & 0xffff0000u)}; }
template <bool SRCF32>
struct EpiResid {
    const void* src_lat; const void* src_ctx; pg8::bf16_t* dst_lat; pg8::bf16_t* dst_ctx; const float* mod; int gchunk;
    __device__ __forceinline__ void operator()(const pg8::f32x4 (&acc)[2][2][4][2], const pg8::Unit& u, int wr, int wc) const {
        const int lane_ = lane_id(), fr = lane_ & 15, fq = lane_ >> 4;
        const int b = u.po / 9, j = u.po - b * 9;
        const char* s; pg8::bf16_t* d; const float* gt; size_t o;
        if (j == 0) { o = (size_t)b * NCTX * DM; s = (const char*)src_ctx; d = dst_ctx; gt = mod + 16 * 6144 + gchunk * DM; }
        else { o = ((size_t)b * SEQ + (size_t)(j - 1) * 256) * DM; s = (const char*)src_lat; d = dst_lat; gt = mod + b * 6144 + gchunk * DM; }
        const int row0 = wr * 64 + fr, col0 = u.pc * 256 + wc * 32 + 8 * fq;
        pg8::f32x4 gv[2][2];
#pragma unroll
        for (int bj = 0; bj < 2; ++bj)
#pragma unroll
            for (int n = 0; n < 2; ++n) gv[bj][n] = *(const pg8::f32x4*)(gt + col0 + bj * 128 + 4 * n);
#pragma unroll
        for (int ai = 0; ai < 2; ++ai)
#pragma unroll
            for (int m = 0; m < 4; ++m) { const size_t ro = o + (size_t)(row0 + ai * 128 + m * 16) * DM + col0;
#pragma unroll
                for (int bj = 0; bj < 2; ++bj) { pg8::f32x4 x0, x1;
                    if constexpr (SRCF32) { const float* sp = (const float*)s + ro + bj * 128; x0 = *(const pg8::f32x4*)sp; x1 = *(const pg8::f32x4*)(sp + 4); }
                    else { const pg8::u32x4 w = *(const pg8::u32x4*)((const pg8::bf16_t*)s + ro + bj * 128); x0 = bf4lo(w.x, w.y); x1 = bf4lo(w.z, w.w); }
                    const pg8::f32x4 r0 = x0 + gv[bj][0] * acc[ai][bj][m][0], r1 = x1 + gv[bj][1] * acc[ai][bj][m][1];
                    pg8::u32x4 wv; wv.x = pg8::cvt_pk_bf16(r0[0], r0[1]); wv.y = pg8::cvt_pk_bf16(r0[2], r0[3]); wv.z = pg8::cvt_pk_bf16(r1[0], r1[1]); wv.w = pg8::cvt_pk_bf16(r1[2], r1[3]);
                    *(pg8::u32x4*)(d + ro + bj * 128) = wv; } }
    }
};

struct EpiPartF32 {
    static constexpr int NST = 32;
    float* part;
    __device__ __forceinline__ void operator()(const pg8::f32x4 (&acc)[2][2][4][2], const pg8::Unit& u, int wr, int wc) const {
        const int lane_ = lane_id(), fr = lane_ & 15, fq = lane_ >> 4;
        float* d = part + ((size_t)(u.pc >> 2) * 2048 + (size_t)u.po * 256) * DM;
        const int row0 = wr * 64 + fr, col0 = (u.pc & 3) * 256 + wc * 32 + 8 * fq;
#pragma unroll
        for (int ai = 0; ai < 2; ++ai)
#pragma unroll
            for (int m = 0; m < 4; ++m) { const size_t ro = (size_t)(row0 + ai * 128 + m * 16) * DM + col0;
#pragma unroll
                for (int bj = 0; bj < 2; ++bj)
#pragma unroll
                    for (int n = 0; n < 2; ++n) *(pg8::f32x4*)(d + ro + bj * 128 + 4 * n) = acc[ai][bj][m][n]; }
    }
};

struct EpiCtxSplit {
    static constexpr int NST = 0;
    const pg8::bf16_t* src_ctx; pg8::bf16_t* dst_ctx; const float* gate; float* part;
    __device__ __forceinline__ void operator()(const pg8::f32x4 (&acc)[2][2][4][2], const pg8::Unit& u, int wr, int wc) const {
        const int lane_ = lane_id(), fr = lane_ & 15, fq = lane_ >> 4;
        const int b = u.po / 9, ks = u.pc >> 2;
        const int row0 = wr * 64 + fr, col0 = (u.pc & 3) * 256 + wc * 32 + 8 * fq;
        if (ks == 0) {
            const pg8::bf16_t* s = src_ctx + (size_t)b * NCTX * DM; pg8::bf16_t* d = dst_ctx + (size_t)b * NCTX * DM;
            pg8::f32x4 gv[2][2];
#pragma unroll
            for (int bj = 0; bj < 2; ++bj)
#pragma unroll
                for (int n = 0; n < 2; ++n) gv[bj][n] = *(const pg8::f32x4*)(gate + col0 + bj * 128 + 4 * n);
#pragma unroll
            for (int ai = 0; ai < 2; ++ai)
#pragma unroll
                for (int m = 0; m < 4; ++m) { const size_t ro = (size_t)(row0 + ai * 128 + m * 16) * DM + col0;
#pragma unroll
                    for (int bj = 0; bj < 2; ++bj) { const pg8::u32x4 w = *(const pg8::u32x4*)(s + ro + bj * 128);
                        const pg8::f32x4 r0 = bf4lo(w.x, w.y) + gv[bj][0] * acc[ai][bj][m][0], r1 = bf4lo(w.z, w.w) + gv[bj][1] * acc[ai][bj][m][1];
                        pg8::u32x4 wv; wv.x = pg8::cvt_pk_bf16(r0[0], r0[1]); wv.y = pg8::cvt_pk_bf16(r0[2], r0[3]); wv.z = pg8::cvt_pk_bf16(r1[0], r1[1]); wv.w = pg8::cvt_pk_bf16(r1[2], r1[3]);
                        *(pg8::u32x4*)(d + ro + bj * 128) = wv; } }
        } else {
            float* d = part + ((size_t)(ks - 1) * (NB * NCTX) + (size_t)b * NCTX) * DM;
#pragma unroll
            for (int ai = 0; ai < 2; ++ai)
#pragma unroll
                for (int m = 0; m < 4; ++m) { const size_t ro = (size_t)(row0 + ai * 128 + m * 16) * DM + col0;
#pragma unroll
                    for (int bj = 0; bj < 2; ++bj)
#pragma unroll
                        for (int n = 0; n < 2; ++n) *(pg8::f32x4*)(d + ro + bj * 128 + 4 * n) = acc[ai][bj][m][n]; }
        }
    }
};

__device__ __forceinline__ void transpose_item(const float* W, int K, int N, bf16* WT, int drow0, int k0, int n0, LAS float* scr, int lane) {
    float tv[32];
    const float* Wl = W + (size_t)(k0 + (lane >> 5)) * N + n0 + (lane & 31);
#pragma unroll
    for (int i = 0; i < 32; ++i) tv[i] = __builtin_nontemporal_load(Wl + (size_t)(2 * i) * N);
#pragma unroll
    for (int i = 0; i < 32; ++i) scr[(2 * i + (lane >> 5)) * 33 + (lane & 31)] = tv[i];
    LDS_WAIT(); asm volatile("" ::: "memory");
    const int c = lane & 7;
#pragma unroll
    for (int j = 0; j < 4; ++j) { const int n = (lane >> 3) + 8 * j; const LAS float* s = scr + (8 * c) * 33 + n;
        v4u o; o.x = pk2(s[0 * 33], s[1 * 33]); o.y = pk2(s[2 * 33], s[3 * 33]); o.z = pk2(s[4 * 33], s[5 * 33]); o.w = pk2(s[6 * 33], s[7 * 33]);
        *(GAS v4u*)(WT + (size_t)(drow0 + n) * K + k0 + 8 * c) = o; }
    LDS_WAIT(); asm volatile("" ::: "memory");
}
__device__ __forceinline__ void tr_plain(const float* W, int K, int N, bf16* WT, int row_off, int item, LAS float* scr, int lane) {
    const int nblk = N / 32, kb = item / nblk, nb = item - kb * nblk;
    transpose_item(W, K, N, WT, row_off + 32 * nb, 64 * kb, 32 * nb, scr, lane);
}
__device__ __forceinline__ void tr_gu(const float* W, int K, int N, bf16* WT, int row_off, int up, int item, LAS float* scr, int lane) {
    const int nblk = N / 32, kb = item / nblk, nb = item - kb * nblk, n0 = 32 * nb;
    transpose_item(W, K, N, WT, row_off + (n0 >> 7) * 256 + up * 128 + (n0 & 127), 64 * kb, n0, scr, lane);
}

__device__ __forceinline__ void p0_prologue(const Frame& F, const Args& a) {
    const int F_lane = lane_id(), F_tid = F.wave * 64 + F_lane; (void)F_tid;
    unsigned char* ws = a.ws;
    {
        LAS float* sc = (LAS float*)F.lds;
        LAS float* part = (LAS float*)(F.lds + 17 * 1024 * 4);
        bool loaded = false;
        for (int u = blockIdx.x; u < 192; u += F.G) {
            if (!loaded) {
                { float cv[34];
#pragma unroll
                  for (int j = 0; j < 34; ++j) { const int i = F_tid + j * NTHR; cv[j] = (i < 16 * 1024) ? a.in[I_C][i] : a.in[I_CCTX][i - 16 * 1024]; }
#pragma unroll
                  for (int j = 0; j < 34; ++j) sc[F_tid + j * NTHR] = silu_f(cv[j]); }
                loaded = true;
            }
            __syncthreads();
            const int l = u / 96, cb = u - l * 96;
            const float* W = a.in[I_WMOD] + (size_t)l * DM * 6144 + cb * 64 + F_lane;
            float acc[17];
#pragma unroll
            for (int r = 0; r < 17; ++r) acc[r] = 0.f;
            const int k0 = F.wave * 128;
            for (int kk = 0; kk < 128; kk += 16) { float w[16];
#pragma unroll
                for (int j = 0; j < 16; ++j) w[j] = __builtin_nontemporal_load(W + (size_t)(k0 + kk + j) * 6144);
#pragma unroll
                for (int j = 0; j < 16; ++j)
#pragma unroll
                    for (int r = 0; r < 17; ++r) acc[r] += sc[r * 1024 + k0 + kk + j] * w[j]; }
#pragma unroll
            for (int r = 0; r < 17; ++r) part[(F.wave * 17 + r) * 64 + F_lane] = acc[r];
            __syncthreads();
            float* MOD = (float*)(ws + WS_MOD) + (size_t)l * 17 * 6144;
            for (int o = F_tid; o < 17 * 64; o += NTHR) { const int r = o >> 6, c = o & 63; float s = a.in[I_BMOD][l * 6144 + cb * 64 + c];
#pragma unroll
                for (int w = 0; w < 8; ++w) s += part[(w * 17 + r) * 64 + c];
                MOD[r * 6144 + cb * 64 + c] = s; }
        }
        __syncthreads();
    }
    LAS float* scr = (LAS float*)(F.lds + F.wave * 16384);
    const int gw = F.vcu * NWAVES + F.wave, NGW = F.G * NWAVES;
    constexpr int I_AB = 16 * 73, I_SQ = 16 * 32, I_FG = 16 * 112, I_FD = 56 * 32, I_IC = 16 * 96;
    constexpr int NITEMS = I_AB + I_SQ + 2 * I_FG + I_FD + I_IC + I_SQ;
    const int nitems0 = F.G > 128 ? I_AB : NITEMS;
    for (int it = gw; it < nitems0; it += NGW) {
        int r = it;
        if (r < I_AB) { tr_plain(a.in[I_WINAB], DM, ABW, (bf16*)(ws + WS_WINAB), 0, r, scr, F_lane); continue; } r -= I_AB;
        if (r < I_SQ) { tr_plain(a.in[I_WOUTAB], DM, DM, (bf16*)(ws + WS_WOUTAB), 0, r, scr, F_lane); continue; } r -= I_SQ;
        if (r < I_FG) { tr_gu(a.in[I_WFFG], DM, DFF, (bf16*)(ws + WS_WFF1), 0, 0, r, scr, F_lane); continue; } r -= I_FG;
        if (r < I_FG) { tr_gu(a.in[I_WFFU], DM, DFF, (bf16*)(ws + WS_WFF1), 0, 1, r, scr, F_lane); continue; } r -= I_FG;
        if (r < I_FD) { tr_plain(a.in[I_WFFD], DFF, DM, (bf16*)(ws + WS_WFF2), 0, r, scr, F_lane); continue; } r -= I_FD;
        if (r < I_IC) { tr_plain(a.in[I_WINC], DM, QKVW, (bf16*)(ws + WS_WINC), 0, r, scr, F_lane); continue; } r -= I_IC;
        tr_plain(a.in[I_WOUTC], DM, DM, (bf16*)(ws + WS_WOUTC), 0, r, scr, F_lane);
    }
    { GAS v4u* z = (GAS v4u*)(ws + WS_WINAB + (size_t)ABW * DM * 2); const int n16 = (ABP - ABW) * DM * 2 / 16;
      for (int i = blockIdx.x * NTHR + F_tid; i < n16; i += F.G * NTHR) z[i] = (v4u){0u, 0u, 0u, 0u}; }
}

struct TrIt { const float* Wl; bf16* dst; int N, K; };
__device__ __forceinline__ void tr_issue(const TrIt& t, float (&tv)[32]) {
#pragma unroll
    for (int i = 0; i < 32; ++i) tv[i] = __builtin_nontemporal_load(t.Wl + (size_t)(2 * i) * t.N);
}
__device__ __forceinline__ void tr_finish(const TrIt& t, const float (&tv)[32], LAS float* scr, int lane) {
#pragma unroll
    for (int i = 0; i < 32; ++i) scr[(2 * i + (lane >> 5)) * 33 + (lane & 31)] = tv[i];
    LDS_WAIT(); asm volatile("" ::: "memory");
    const int c = lane & 7;
#pragma unroll
    for (int j = 0; j < 4; ++j) { const int n = (lane >> 3) + 8 * j; const LAS float* sp = scr + (8 * c) * 33 + n;
        v4u o; o.x = pk2(sp[0 * 33], sp[1 * 33]); o.y = pk2(sp[2 * 33], sp[3 * 33]); o.z = pk2(sp[4 * 33], sp[5 * 33]); o.w = pk2(sp[6 * 33], sp[7 * 33]);
        *(GAS v4u*)(t.dst + (size_t)n * t.K + 8 * c) = o; }
    LDS_WAIT(); asm volatile("" ::: "memory");
}
__device__ __forceinline__ TrIt moe_item(const Args& a, int it, int lane) {
    constexpr int I_FG = 16 * 112, I_FD = 56 * 32, PER = 2 * I_FG + I_FD;
    unsigned char* ws = a.ws;
    const int e = it / PER; int r = it - e * PER; TrIt t;
    if (r < 2 * I_FG) { const int up = r >= I_FG ? 1 : 0; r -= up * I_FG; const float* W = (up ? a.in[I_WMU] : a.in[I_WMG]) + (size_t)e * DM * DFF;
        const int nblk = DFF / 32, kb = r / nblk, nb = r - kb * nblk, n0 = 32 * nb, k0 = 64 * kb, drow0 = e * 2 * DFF + (n0 >> 7) * 256 + up * 128 + (n0 & 127);
        t.N = DFF; t.K = DM; t.Wl = W + (size_t)(k0 + (lane >> 5)) * DFF + n0 + (lane & 31); t.dst = (bf16*)(ws + WS_WMOE1) + (size_t)drow0 * DM + k0; }
    else { r -= 2 * I_FG; const float* W = a.in[I_WMD] + (size_t)e * DFF * DM;
        const int nblk = DM / 32, kb = r / nblk, nb = r - kb * nblk, n0 = 32 * nb, k0 = 64 * kb, drow0 = e * DM + n0;
        t.N = DM; t.K = DFF; t.Wl = W + (size_t)(k0 + (lane >> 5)) * DM + n0 + (lane & 31); t.dst = (bf16*)(ws + WS_WMOE2) + (size_t)drow0 * DFF + k0; }
    return t;
}
constexpr int DN_SQ = 16 * 32, DN_FG = 16 * 112, DN_FD = 56 * 32, DN_IC = 16 * 96, DN_ITEMS = DN_SQ + 2 * DN_FG + DN_FD + DN_IC + DN_SQ;
__device__ __forceinline__ TrIt tr_plain_item(const float* W, int K, int N, bf16* WT, int r, int lane) {
    const int nblk = N / 32, kb = r / nblk, nb = r - kb * nblk, n0 = 32 * nb, k0 = 64 * kb; TrIt t;
    t.N = N; t.K = K; t.Wl = W + (size_t)(k0 + (lane >> 5)) * N + n0 + (lane & 31); t.dst = WT + (size_t)n0 * K + k0; return t;
}
__device__ __forceinline__ TrIt dense_item(const Args& a, int r, int lane) {
    unsigned char* ws = a.ws;
    if (r < DN_SQ) return tr_plain_item(a.in[I_WOUTAB], DM, DM, (bf16*)(ws + WS_WOUTAB), r, lane); r -= DN_SQ;
    if (r < 2 * DN_FG) { const int up = r >= DN_FG ? 1 : 0; r -= up * DN_FG; const float* W = up ? a.in[I_WFFU] : a.in[I_WFFG];
        const int nblk = DFF / 32, kb = r / nblk, nb = r - kb * nblk, n0 = 32 * nb, k0 = 64 * kb, drow0 = (n0 >> 7) * 256 + up * 128 + (n0 & 127); TrIt t;
        t.N = DFF; t.K = DM; t.Wl = W + (size_t)(k0 + (lane >> 5)) * DFF + n0 + (lane & 31); t.dst = (bf16*)(ws + WS_WFF1) + (size_t)drow0 * DM + k0; return t; }
    r -= 2 * DN_FG;
    if (r < DN_FD) return tr_plain_item(a.in[I_WFFD], DFF, DM, (bf16*)(ws + WS_WFF2), r, lane); r -= DN_FD;
    if (r < DN_IC) return tr_plain_item(a.in[I_WINC], DM, QKVW, (bf16*)(ws + WS_WINC), r, lane); r -= DN_IC;
    return tr_plain_item(a.in[I_WOUTC], DM, DM, (bf16*)(ws + WS_WOUTC), r, lane);
}
__device__ __forceinline__ void moe_weights_convert(const Frame& F, const Args& a, int first, int count) {
    const int F_lane = lane_id();
    const int me = (int)blockIdx.x - first; if (me < 0 || me >= count) return;
    LAS float* scr = (LAS float*)(F.lds + F.wave * 16384);
    constexpr int PERX = 2 * 16 * 112 + 56 * 32, NMOE = 8 * PERX, NIT = NMOE + DN_ITEMS;
#define CV_ITEM(i) ((i) < DN_ITEMS ? dense_item(a, (i), F_lane) : moe_item(a, (i) - DN_ITEMS, F_lane))
    const int st = count * NWAVES; int it = me * NWAVES + F.wave;
    if (it >= NIT) return;
    float tvA[32], tvB[32];
    TrIt A = CV_ITEM(it), B = A; tr_issue(A, tvA);
    for (;;) {
        const bool hasB = it + st < NIT; if (hasB) { B = CV_ITEM(it + st); tr_issue(B, tvB); }
        tr_finish(A, tvA, scr, F_lane);
        if (!hasB) break;
        it += 2 * st; const bool hasA = it < NIT; if (hasA) { A = CV_ITEM(it); tr_issue(A, tvA); }
        tr_finish(B, tvB, scr, F_lane);
        if (!hasA) break;
    }
}
__device__ __forceinline__ void moe_weights_convert_old(const Frame& F, const Args& a, int first, int count) {
    const int F_lane = lane_id(), F_tid = F.wave * 64 + F_lane; (void)F_tid;
    const int me = (int)blockIdx.x - first; if (me < 0 || me >= count) return;
    unsigned char* ws = a.ws;
    LAS float* scr = (LAS float*)(F.lds + F.wave * 16384);
    constexpr int I_FG = 16 * 112, I_FD = 56 * 32, PER = 2 * I_FG + I_FD;
    for (int it = me * NWAVES + F.wave; it < 8 * PER; it += count * NWAVES) {
        const int e = it / PER; int r = it - e * PER;
        if (r < I_FG) { tr_gu(a.in[I_WMG] + (size_t)e * DM * DFF, DM, DFF, (bf16*)(ws + WS_WMOE1), e * 2 * DFF, 0, r, scr, F_lane); continue; } r -= I_FG;
        if (r < I_FG) { tr_gu(a.in[I_WMU] + (size_t)e * DM * DFF, DM, DFF, (bf16*)(ws + WS_WMOE1), e * 2 * DFF, 1, r, scr, F_lane); continue; } r -= I_FG;
        tr_plain(a.in[I_WMD] + (size_t)e * DFF * DM, DFF, DM, (bf16*)(ws + WS_WMOE2), e * DM, r, scr, F_lane);
    }
}

__device__ __forceinline__ void norm_mod_row(const float* xrow, const float* g, const float* sh, const float* scl, bf16* orow, int lane, f32x4 (&hv)[4]) {
    const GAS f32x4* xr = (const GAS f32x4*)xrow + lane;
    float s = 0.f;
#pragma unroll
    for (int j = 0; j < 4; ++j) { hv[j] = xr[64 * j]; s += (hv[j].x * hv[j].x + hv[j].y * hv[j].y) + (hv[j].z * hv[j].z + hv[j].w * hv[j].w); }
    const float rstd = 1.f / sqrtf(wave_sum(s) * (1.f / DM) + EPS);
    GAS v2u* o8 = (GAS v2u*)orow + lane;
#pragma unroll
    for (int j = 0; j < 4; ++j) {
        const f32x4 gg = ((const GAS f32x4*)g)[64 * j + lane], s1 = ((const GAS f32x4*)scl)[64 * j + lane], s0 = ((const GAS f32x4*)sh)[64 * j + lane];
        hv[j] = hv[j] * rstd * gg * (s1 + 1.f) + s0;
        v2u w; w.x = pk2(hv[j].x, hv[j].y); w.y = pk2(hv[j].z, hv[j].w); o8[64 * j] = w;
    }
}
__device__ __forceinline__ void norm_mod_vals(const float* g, const float* sh, const float* scl, bf16* orow, int lane, f32x4 (&hv)[4]) {
    float s = 0.f;
#pragma unroll
    for (int j = 0; j < 4; ++j) s += (hv[j].x * hv[j].x + hv[j].y * hv[j].y) + (hv[j].z * hv[j].z + hv[j].w * hv[j].w);
    const float rstd = 1.f / sqrtf(wave_sum(s) * (1.f / DM) + EPS);
    GAS v2u* o8 = (GAS v2u*)orow + lane;
#pragma unroll
    for (int j = 0; j < 4; ++j) { const f32x4 gg = ((const GAS f32x4*)g)[64 * j + lane], s1 = ((const GAS f32x4*)scl)[64 * j + lane], s0 = ((const GAS f32x4*)sh)[64 * j + lane];
        const f32x4 h = hv[j] * rstd * gg * (s1 + 1.f) + s0; v2u w; w.x = pk2(h.x, h.y); w.y = pk2(h.z, h.w); o8[64 * j] = w; }
}
template <bool XBF>
__device__ __forceinline__ void norm_mod_rows4(const void* const (&xrow)[4], const float* g, const float* sh, const float* scl, bf16* const (&orow)[4], int lane, f32x4 (&hv)[4][4]) {
#pragma unroll
    for (int q = 0; q < 4; ++q) {
        if constexpr (XBF) { const GAS v2u* xr = (const GAS v2u*)xrow[q] + lane;
#pragma unroll
            for (int j = 0; j < 4; ++j) { const v2u w = __builtin_nontemporal_load(xr + 64 * j); hv[q][j] = (f32x4){bflo(w.x), bfhi(w.x), bflo(w.y), bfhi(w.y)}; } }
        else { const GAS f32x4* xr = (const GAS f32x4*)xrow[q] + lane;
#pragma unroll
            for (int j = 0; j < 4; ++j) hv[q][j] = __builtin_nontemporal_load(xr + 64 * j); } }
    f32x4 gg[4], s1[4], s0[4];
#pragma unroll
    for (int j = 0; j < 4; ++j) { gg[j] = ((const GAS f32x4*)g)[64 * j + lane]; s1[j] = ((const GAS f32x4*)scl)[64 * j + lane] + 1.f; s0[j] = ((const GAS f32x4*)sh)[64 * j + lane]; gg[j] = gg[j] * s1[j]; }
#pragma unroll
    for (int q = 0; q < 4; ++q) { float s = 0.f;
#pragma unroll
        for (int j = 0; j < 4; ++j) s += (hv[q][j].x * hv[q][j].x + hv[q][j].y * hv[q][j].y) + (hv[q][j].z * hv[q][j].z + hv[q][j].w * hv[q][j].w);
        const float rstd = 1.f / sqrtf(wave_sum(s) * (1.f / DM) + EPS);
        GAS v2u* o8 = (GAS v2u*)orow[q] + lane;
#pragma unroll
        for (int j = 0; j < 4; ++j) { hv[q][j] = hv[q][j] * rstd * gg[j] + s0[j]; v2u w; w.x = pk2(hv[q][j].x, hv[q][j].y); w.y = pk2(hv[q][j].z, hv[q][j].w); o8[64 * j] = w; } }
}
template <bool XBF>
__device__ __forceinline__ void norm_phase(const Frame& F, const Args& a, int l, int which, const void* lat, const void* ctx, const float* gvec, const float* pgate) {
    const int F_lane = lane_id(), F_tid = F.wave * 64 + F_lane; (void)F_tid;
    const float* MOD = (const float*)(a.ws + WS_MOD) + (size_t)l * 17 * 6144;
    bf16* HB = (bf16*)a.out;
    const int gw = F.vcu * NWAVES + F.wave, NGW = F.G * NWAVES;
    for (int r4 = gw; r4 < MROWS / 4; r4 += NGW) {
        const int r = 4 * r4, b = r / TOT, t = r - b * TOT;
        const float* m = MOD + (t < NCTX ? 16 : b) * 6144 + which * 3 * DM;
        if (pgate && t < NCTX) {
            const float* PART = (const float*)(a.ws + WS_PARTC);
#pragma unroll
            for (int q = 0; q < 4; ++q) { const size_t cr = (size_t)(b * NCTX + t + q) * DM; const GAS v2u* xr = (const GAS v2u*)((const bf16*)ctx + cr) + F_lane; f32x4 hv[4];
#pragma unroll
                for (int j = 0; j < 4; ++j) { const f32x4 p1 = ((const GAS f32x4*)(PART + cr))[64 * j + F_lane], p2 = ((const GAS f32x4*)(PART + (size_t)NB * NCTX * DM + cr))[64 * j + F_lane], p3 = ((const GAS f32x4*)(PART + 2 * (size_t)NB * NCTX * DM + cr))[64 * j + F_lane];
                    const f32x4 g = ((const GAS f32x4*)pgate)[64 * j + F_lane]; const v2u w = xr[64 * j]; hv[j] = (f32x4){bflo(w.x), bfhi(w.x), bflo(w.y), bfhi(w.y)} + g * ((p1 + p2) + p3); }
                norm_mod_vals(gvec, m, m + DM, HB + (size_t)(r + q) * DM, F_lane, hv); }
            continue; }
        const size_t xo = (t < NCTX ? (size_t)(b * NCTX + t) : (size_t)(b * SEQ + t - NCTX)) * DM * (XBF ? 2 : 4), xp = (size_t)DM * (XBF ? 2 : 4);
        const char* x0 = (const char*)(t < NCTX ? ctx : lat) + xo;
        const void* const xr[4] = {x0, x0 + xp, x0 + 2 * xp, x0 + 3 * xp};
        bf16* const orw[4] = {HB + (size_t)r * DM, HB + (size_t)(r + 1) * DM, HB + (size_t)(r + 2) * DM, HB + (size_t)(r + 3) * DM};
        f32x4 hv[4][4];
        norm_mod_rows4<XBF>(xr, gvec, m, m + DM, orw, F_lane, hv);
    }
}

__device__ __forceinline__ void qkprep_phase(const Frame& F, const Args& a) {
    const int lane = lane_id(), g = lane >> 4, l16 = lane & 15;
    bf16* P = (bf16*)(a.ws + WS_PROJ0);
    const int gw = F.vcu * NWAVES + F.wave, NGW = F.G * NWAVES;
    const f32x4 gq = *(const GAS f32x4*)(a.in[I_GQ] + 4 * l16), gk = *(const GAS f32x4*)(a.in[I_GK] + 4 * l16);
    const float inv0 = fexp2(-(float)((2 * l16) & 15) * (13.287712379549449f / 16.f)), inv1 = fexp2(-(float)((2 * l16 + 1) & 15) * (13.287712379549449f / 16.f));
    for (int r4 = gw; r4 < MROWS / 4; r4 += NGW) {
        v2u raw[10];
#pragma unroll
        for (int p = 0; p < 10; ++p) { const int s = 4 * p + g, rl = s / 10, hv = s - rl * 10; raw[p] = *(const GAS v2u*)(P + (size_t)(4 * r4 + rl) * ABP + hv * 64 + 4 * l16); }
#pragma unroll
        for (int p = 0; p < 10; ++p) { const int s = 4 * p + g, rl = s / 10, hv = s - rl * 10, r = 4 * r4 + rl, b = r / TOT, t = r - b * TOT;
            f32x4 v = {bflo(raw[p].x), bfhi(raw[p].x), bflo(raw[p].y), bfhi(raw[p].y)};
            float ss = (v.x * v.x + v.y * v.y) + (v.z * v.z + v.w * v.w);
#pragma unroll
            for (int o = 1; o < 16; o <<= 1) ss += __shfl_xor(ss, o);
            const float rs = 1.f / sqrtf(ss * (1.f / 64.f) + EPS) * (hv < 8 ? 0.125f * LOG2E : 1.f);
            v = v * rs * (hv < 8 ? gq : gk);
            if (t >= NCTX) { const int tl = t - NCTX; const float pos = (float)((l16 < 8) ? (tl >> 6) : (tl & 63));
                const float rv0 = pos * inv0 * 0.15915494309189535f, rv1 = pos * inv1 * 0.15915494309189535f; const float f0 = rv0 - floorf(rv0), f1 = rv1 - floorf(rv1);
                const float c0 = __builtin_amdgcn_cosf(f0), s0 = __builtin_amdgcn_sinf(f0), c1 = __builtin_amdgcn_cosf(f1), s1 = __builtin_amdgcn_sinf(f1);
                v = (f32x4){v.x * c0 - v.y * s0, v.x * s0 + v.y * c0, v.z * c1 - v.w * s1, v.z * s1 + v.w * c1}; }
            v2u w; w.x = pk2(v.x, v.y); w.y = pk2(v.z, v.w);
            *(GAS v2u*)(P + (size_t)r * ABP + hv * 64 + 4 * l16) = w; }
    }
}

typedef float f32x2_cv __attribute__((ext_vector_type(2))); typedef __bf16 bf16x2_cv __attribute__((ext_vector_type(2)));
__device__ __forceinline__ unsigned cvt_pk_c(float lo, float hi) { const f32x2_cv v = {lo, hi}; const bf16x2_cv b = __builtin_convertvector(v, bf16x2_cv); return __builtin_bit_cast(unsigned, b); }
__device__ __forceinline__ void gla_mfma_phase(const Frame& F, const Args& a) {
    typedef short bf16x8 __attribute__((ext_vector_type(8)));
    typedef short s16x4 __attribute__((ext_vector_type(4)));
    typedef short v4i16_t __attribute__((ext_vector_type(4)));
    typedef float f32x16 __attribute__((ext_vector_type(16)));
    constexpr int PT = 72, PV = 136;
    const bf16* P = (const bf16*)(a.ws + WS_PROJ0);
    LAS bf16* Qd = (LAS bf16*)F.lds;
    LAS bf16* Ki = Qd + 64 * PT;
    LAS bf16* Vv = Ki + 64 * PT;
    LAS bf16* ST = Vv + 64 * PV;
    LAS float* dec = (LAS float*)(ST + 2 * 128 * PT);
    LAS float* w2s = dec + 64;
    LAS bf16* Ob = (LAS bf16*)(w2s + 17 * 64);
    const int lane = lane_id(), w = F.wave, tid = w * 64 + lane, r32 = lane & 31, hi = lane >> 5;
    const int trr = (lane & 15) >> 2, trc = 16 * ((lane >> 4) & 1) + 4 * (lane & 3);
#define GLA_TR(p) __builtin_bit_cast(s16x4, __builtin_amdgcn_ds_read_tr16_b64_v4i16((LAS v4i16_t*)(p)))
#define GLA_CAT(lo, hi4) (bf16x8){lo[0], lo[1], lo[2], lo[3], hi4[0], hi4[1], hi4[2], hi4[3]}
#define GLA_CROW(r) (((r) & 3) + 8 * ((r) >> 2) + 4 * hi)
    for (int u = blockIdx.x; u < 128; u += F.G) {
        const int dir = u & 1, h = (u >> 1) & 3, b = u >> 3;
        const float* w2 = a.in[dir ? I_WA2B : I_WA2F]; const float* ba = a.in[dir ? I_BAB : I_BAF];
        bf16* O = (bf16*)(a.ws + (dir ? WS_GLAR : WS_GLAF));
        __syncthreads();
        for (int i = tid; i < 17 * 64; i += NTHR) w2s[i] = (i < 1024) ? w2[(i >> 6) * 256 + h * 64 + (i & 63)] : ba[h * 64 + (i & 63)];
        for (int i = tid; i < 128 * PT / 2; i += NTHR) ((LAS unsigned*)ST)[i] = 0u;
        f32x16 S;
#pragma unroll
        for (int r = 0; r < 16; ++r) S[r] = 0.f;
        v4u rq, rk, rz0, rz1, rv0, rv1;
        const int vtok = tid >> 3, vseg = tid & 7;
#define GLA_TOK(p) (dir == 0 ? (p) : ((p) < NCTX ? NCTX - 1 - (p) : TOT + NCTX - 1 - (p)))
#define GLA_LOAD(n) do { const bf16* rowA = P + (size_t)(b * TOT + GLA_TOK((n) * 64 + lane)) * ABP; const bf16* rowB = P + (size_t)(b * TOT + GLA_TOK((n) * 64 + vtok)) * ABP; \
        rq = *(const GAS v4u*)(rowA + PB_Q + h * 64 + 8 * w); rk = *(const GAS v4u*)(rowA + PB_K + h * 64 + 8 * w); rz0 = *(const GAS v4u*)(rowA + PZ_F + dir * 16); rz1 = *(const GAS v4u*)(rowA + PZ_F + dir * 16 + 8); \
        rv0 = *(const GAS v4u*)(rowB + PB_V + h * 128 + 16 * vseg); rv1 = *(const GAS v4u*)(rowB + PB_V + h * 128 + 16 * vseg + 8); } while (0)
        GLA_LOAD(0);
        for (int n = 0; n < TOT / 64; ++n) {
            LDS_BARRIER();
            if (n > 0) { const v4u ov0 = *(const LAS v4u*)(Ob + vtok * PV + 16 * vseg), ov1 = *(const LAS v4u*)(Ob + vtok * PV + 16 * vseg + 8);
                bf16* op = O + (size_t)(b * TOT + GLA_TOK((n - 1) * 64 + vtok)) * 512 + h * 128 + 16 * vseg; *(GAS v4u*)op = ov0; *(GAS v4u*)(op + 8) = ov1; }
            {
                float z[16];
                z[0] = bflo(rz0.x); z[1] = bfhi(rz0.x); z[2] = bflo(rz0.y); z[3] = bfhi(rz0.y); z[4] = bflo(rz0.z); z[5] = bfhi(rz0.z); z[6] = bflo(rz0.w); z[7] = bfhi(rz0.w);
                z[8] = bflo(rz1.x); z[9] = bfhi(rz1.x); z[10] = bflo(rz1.y); z[11] = bfhi(rz1.y); z[12] = bflo(rz1.z); z[13] = bfhi(rz1.z); z[14] = bflo(rz1.w); z[15] = bfhi(rz1.w);
                f32x4 u0 = *(const LAS f32x4*)(w2s + 1024 + 8 * w), u1 = *(const LAS f32x4*)(w2s + 1024 + 8 * w + 4);
#pragma unroll
                for (int rb = 0; rb < 16; rb += 8) {
                    f32x4 wa[8], wb[8];
#pragma unroll
                    for (int r = 0; r < 8; ++r) { wa[r] = *(const LAS f32x4*)(w2s + (rb + r) * 64 + 8 * w); wb[r] = *(const LAS f32x4*)(w2s + (rb + r) * 64 + 8 * w + 4); }
                    asm volatile("s_waitcnt lgkmcnt(0)" ::: "memory");
#pragma unroll
                    for (int r = 0; r < 8; ++r) { u0 += wa[r] * z[rb + r]; u1 += wb[r] * z[rb + r]; } }
                float la[8];
#pragma unroll
                for (int c = 0; c < 8; ++c) { const float uu = c < 4 ? u0[c & 3] : u1[c & 3]; la[c] = -(fmaxf(-uu, 0.f) * LOG2E + __builtin_amdgcn_logf(1.f + fexp2(-fabsf(uu) * LOG2E))) * (1.f / 16.f); }
#pragma unroll
                for (int o = 1; o < 64; o <<= 1) {
#pragma unroll
                    for (int c = 0; c < 8; ++c) { const float nb = __shfl_up(la[c], o, 64); if (lane >= o) la[c] += nb; } }
                float qv[8], kv[8];
                qv[0] = bflo(rq.x); qv[1] = bfhi(rq.x); qv[2] = bflo(rq.y); qv[3] = bfhi(rq.y); qv[4] = bflo(rq.z); qv[5] = bfhi(rq.z); qv[6] = bflo(rq.w); qv[7] = bfhi(rq.w);
                kv[0] = bflo(rk.x); kv[1] = bfhi(rk.x); kv[2] = bflo(rk.y); kv[3] = bfhi(rk.y); kv[4] = bflo(rk.z); kv[5] = bfhi(rk.z); kv[6] = bflo(rk.w); kv[7] = bfhi(rk.w);
#pragma unroll
                for (int c = 0; c < 8; ++c) { qv[c] *= 0.125f * fexp2(la[c]); kv[c] *= fexp2(-la[c]); }
                v4u wq, wk; wq.x = cvt_pk_c(qv[0], qv[1]); wq.y = cvt_pk_c(qv[2], qv[3]); wq.z = cvt_pk_c(qv[4], qv[5]); wq.w = cvt_pk_c(qv[6], qv[7]);
                wk.x = cvt_pk_c(kv[0], kv[1]); wk.y = cvt_pk_c(kv[2], kv[3]); wk.z = cvt_pk_c(kv[4], kv[5]); wk.w = cvt_pk_c(kv[6], kv[7]);
                *(LAS v4u*)(Qd + lane * PT + 8 * w) = wq; *(LAS v4u*)(Ki + lane * PT + 8 * w) = wk;
                if (lane == 63) {
#pragma unroll
                    for (int c = 0; c < 8; ++c) dec[8 * w + c] = fexp2(la[c]); }
                *(LAS v4u*)(Vv + vtok * PV + 16 * vseg) = rv0; *(LAS v4u*)(Vv + vtok * PV + 16 * vseg + 8) = rv1;
            }
            LDS_BARRIER();
            if (n + 1 < TOT / 64) GLA_LOAD(n + 1);
            LAS bf16* STc = ST + (n & 1) * 128 * PT; LAS bf16* STn = ST + ((n + 1) & 1) * 128 * PT;
            {
                const int j = w >> 2, c = w & 3;
                bf16x8 qf[4];
#pragma unroll
                for (int ks = 0; ks < 4; ++ks) qf[ks] = *(const LAS bf16x8*)(Qd + (32 * j + r32) * PT + 16 * ks + 8 * hi);
                f32x16 o;
#pragma unroll
                for (int r = 0; r < 16; ++r) o[r] = 0.f;
                for (int i = 0; i <= j; ++i) {
                    f32x16 X;
#pragma unroll
                    for (int r = 0; r < 16; ++r) X[r] = 0.f;
#pragma unroll
                    for (int ks = 0; ks < 4; ++ks) { const bf16x8 kf = *(const LAS bf16x8*)(Ki + (32 * i + r32) * PT + 16 * ks + 8 * hi); X = __builtin_amdgcn_mfma_f32_32x32x16_bf16(kf, qf[ks], X, 0, 0, 0); }
                    if (i == j) {
#pragma unroll
                        for (int r = 0; r < 16; ++r) X[r] = (GLA_CROW(r) > r32) ? 0.f : X[r]; }
#pragma unroll
                    for (int sp = 0; sp < 2; ++sp) {
                        v4u pw; pw.x = cvt_pk_c(X[8 * sp + 0], X[8 * sp + 1]); pw.y = cvt_pk_c(X[8 * sp + 2], X[8 * sp + 3]); pw.z = cvt_pk_c(X[8 * sp + 4], X[8 * sp + 5]); pw.w = cvt_pk_c(X[8 * sp + 6], X[8 * sp + 7]);
                        const LAS bf16* vp = Vv + (32 * i + 16 * sp + 4 * hi + trr) * PV + 32 * c + trc;
                        const s16x4 lo = GLA_TR(vp), hi4 = GLA_TR(vp + 8 * PV);
                        o = __builtin_amdgcn_mfma_f32_32x32x16_bf16(__builtin_bit_cast(bf16x8, pw), GLA_CAT(lo, hi4), o, 0, 0, 0);
                    }
                }
#pragma unroll
                for (int ks = 0; ks < 4; ++ks) { const bf16x8 sf = *(const LAS bf16x8*)(STc + (32 * c + r32) * PT + 16 * ks + 8 * hi); o = __builtin_amdgcn_mfma_f32_32x32x16_bf16(qf[ks], sf, o, 0, 0, 0); }
#pragma unroll
                for (int r = 0; r < 16; ++r) Ob[(32 * j + GLA_CROW(r)) * PV + 32 * c + r32] = (bf16)f2bf(o[r]);
            }
            {
                const int a2 = w >> 2, c = w & 3;
#pragma unroll
                for (int ks = 0; ks < 4; ++ks) {
                    const LAS bf16* kp = Ki + (16 * ks + 8 * hi + trr) * PT + 32 * a2 + trc; const LAS bf16* vp = Vv + (16 * ks + 8 * hi + trr) * PV + 32 * c + trc;
                    const s16x4 alo = GLA_TR(kp), ahi = GLA_TR(kp + 4 * PT), blo = GLA_TR(vp), bhi = GLA_TR(vp + 4 * PV);
                    S = __builtin_amdgcn_mfma_f32_32x32x16_bf16(GLA_CAT(alo, ahi), GLA_CAT(blo, bhi), S, 0, 0, 0);
                }
#pragma unroll
                for (int g = 0; g < 4; ++g) { const f32x4 dv = *(const LAS f32x4*)(dec + 32 * a2 + 8 * g + 4 * hi);
                    S[4 * g + 0] *= dv.x; S[4 * g + 1] *= dv.y; S[4 * g + 2] *= dv.z; S[4 * g + 3] *= dv.w;
                    v2u pw; pw.x = cvt_pk_c(S[4 * g + 0], S[4 * g + 1]); pw.y = cvt_pk_c(S[4 * g + 2], S[4 * g + 3]);
                    *(LAS v2u*)(STn + (32 * c + r32) * PT + 32 * a2 + 8 * g + 4 * hi) = pw; }
            }
        }
        __syncthreads();
        { const v4u ov0 = *(const LAS v4u*)(Ob + vtok * PV + 16 * vseg), ov1 = *(const LAS v4u*)(Ob + vtok * PV + 16 * vseg + 8);
          bf16* op = O + (size_t)(b * TOT + GLA_TOK((TOT / 64 - 1) * 64 + vtok)) * 512 + h * 128 + 16 * vseg; *(GAS v4u*)op = ov0; *(GAS v4u*)(op + 8) = ov1; }
#undef GLA_LOAD
#undef GLA_TOK
    }
#undef GLA_TR
#undef GLA_CAT
#undef GLA_CROW
    __syncthreads();
}

__device__ __forceinline__ void gla_combine_phase(const Frame& F, const Args& a) {
    const int F_lane = lane_id(), F_tid = F.wave * 64 + F_lane; (void)F_tid;
    const bf16* P = (const bf16*)(a.ws + WS_PROJ0);
    const bf16* Of = (const bf16*)(a.ws + WS_GLAF); const bf16* Or = (const bf16*)(a.ws + WS_GLAR);
    bf16* O = (bf16*)a.out;
    const int gw = F.vcu * NWAVES + F.wave, NGW = F.G * NWAVES;
    float gg[8];
#pragma unroll
    for (int i = 0; i < 8; ++i) gg[i] = a.in[I_GGLA][(F_lane & 15) * 8 + i];
    constexpr int CB = 3;
    for (int r0 = gw; r0 < MROWS; r0 += CB * NGW) {
        v4u wf[CB], wr_[CB], wg[CB];
#pragma unroll
        for (int q = 0; q < CB; ++q) { const int r = r0 + q * NGW; if (r < MROWS) {
            wf[q] = __builtin_nontemporal_load((const GAS v4u*)(Of + (size_t)r * 512 + F_lane * 8)); wr_[q] = __builtin_nontemporal_load((const GAS v4u*)(Or + (size_t)r * 512 + F_lane * 8));
            wg[q] = *(const GAS v4u*)(P + (size_t)r * ABP + PB_R + F_lane * 8); } }
#pragma unroll
        for (int q = 0; q < CB; ++q) { const int r = r0 + q * NGW; if (r < MROWS) {
            float x[8], rb[8];
            x[0] = bflo(wf[q].x) + bflo(wr_[q].x); x[1] = bfhi(wf[q].x) + bfhi(wr_[q].x); x[2] = bflo(wf[q].y) + bflo(wr_[q].y); x[3] = bfhi(wf[q].y) + bfhi(wr_[q].y);
            x[4] = bflo(wf[q].z) + bflo(wr_[q].z); x[5] = bfhi(wf[q].z) + bfhi(wr_[q].z); x[6] = bflo(wf[q].w) + bflo(wr_[q].w); x[7] = bfhi(wf[q].w) + bfhi(wr_[q].w);
            rb[0] = bflo(wg[q].x); rb[1] = bfhi(wg[q].x); rb[2] = bflo(wg[q].y); rb[3] = bfhi(wg[q].y); rb[4] = bflo(wg[q].z); rb[5] = bfhi(wg[q].z); rb[6] = bflo(wg[q].w); rb[7] = bfhi(wg[q].w);
            float ss = 0.f;
#pragma unroll
            for (int i = 0; i < 8; ++i) ss += x[i] * x[i];
#pragma unroll
            for (int o = 1; o < 16; o <<= 1) ss += __shfl_xor(ss, o);
            const float rs = 1.f / sqrtf(ss * (1.f / 128.f) + EPS);
            float y[8];
#pragma unroll
            for (int i = 0; i < 8; ++i) y[i] = x[i] * rs * gg[i] * silu_f(rb[i]);
            v4u w; w.x = pk2(y[0], y[1]); w.y = pk2(y[2], y[3]); w.z = pk2(y[4], y[5]); w.w = pk2(y[6], y[7]);
            *(GAS v4u*)(O + (size_t)r * DM + 512 + F_lane * 8) = w; } }
    }
}

__device__ __forceinline__ void attnA_unit(const Frame& F, const Args& a, char* lds, int u) {
    const attn_body::bf16* P = (const attn_body::bf16*)(a.ws + WS_PROJ0);
    attn_body::bf16* O = (attn_body::bf16*)a.out;
    int b, h, kvh, NT; long qrow;
    if (u < 1024) { const int grp = u >> 5, w = u & 31; b = grp >> 1; kvh = grp & 1; h = kvh * 4 + (w >> 3); qrow = (long)b * TOT + NCTX + (w & 7) * 256; NT = TOT / 64; }
    else { const int v = u - 1024; b = v >> 3; h = v & 7; kvh = h >> 2; qrow = (long)b * TOT; NT = NCTX / 64; }
    const attn_body::bf16* Kh = P + (long)b * TOT * ABP + PA_K + kvh * 64;
    attn_body::attn_unit<8, ABP, DM, false>(P + qrow * ABP + PA_Q + h * 64, Kh, Kh + (PA_V - PA_K), O + qrow * DM + h * 64, NT, lds, 0, 0, nullptr, F.wave);
}
constexpr int ATTA_MAIN = 768;
__device__ __forceinline__ void attnA_phase(const Frame& F, const Args& a, char* lds) {
    for (int u = F.vcu; u < ATTA_MAIN; u += F.G) attnA_unit(F, a, lds, u);
}
__device__ __forceinline__ void attnA_side(const Frame& F, const Args& a, char* lds) {
    const int j = (int)blockIdx.x - 128; if (j < 0) return;
    if (F.G == 256) { const int x = (int)blockIdx.x & 7, sidx = j >> 3;
        attnA_unit(F, a, lds, ATTA_MAIN + x * 32 + sidx * 2); attnA_unit(F, a, lds, ATTA_MAIN + x * 32 + sidx * 2 + 1); attnA_unit(F, a, lds, 1024 + j); }
    else { const int n = F.G - 128; for (int u = ATTA_MAIN + j; u < 1024 + 128; u += n) attnA_unit(F, a, lds, u); }
}
__device__ __forceinline__ void na_phase(const Frame& F, const Args& a, char* lds) {
    const attn_body::bf16* Q = (const attn_body::bf16*)(a.ws + WS_QKV);
    attn_body::bf16* O = (attn_body::bf16*)a.out;
    int h_built = -1;
    for (int i = 0;; ++i) {
        const int u = F.vcu + i * F.G; if (u >= NB * 16 * 8) break;
        const int bh = u >> 3, r0g = ((u & 7) + i) & 7, b = bh >> 4, h = bh & 15;
        if (h != h_built) { attn_body::na_bias_tables(lds, a.in[I_RPB] + h * 465, F.wave * 64 + lane_id()); h_built = h; __syncthreads(); }
        const int klo = r0g == 0 ? 0 : (r0g == 7 ? 24 : 4 * r0g - 4), NT = (r0g == 0 || r0g == 7) ? 12 : 16;
        const long qrow = (long)b * TOT + NCTX + r0g * 256;
        const attn_body::bf16* Kh = Q + (long)b * TOT * QKVW + DM + h * 64;
        attn_body::attn_unit<8, QKVW, DM, true>(Q + qrow * QKVW + h * 64, Kh, Kh + DM, O + qrow * DM + h * 64, NT, lds, klo, 4 * r0g, a.in[I_RPB] + h * 465, F.wave);
    }
}
__device__ __forceinline__ void router_phase(const Frame& F, const Args& a) {
    const int F_lane = lane_id(), F_tid = F.wave * 64 + F_lane; (void)F_tid;
    const float* MOD = (const float*)(a.ws + WS_MOD) + (size_t)17 * 6144;
    bf16* HB = (bf16*)a.out;
    int* RE = (int*)(a.ws + WS_RE); float* RG = (float*)(a.ws + WS_RG); int* CNT = (int*)(a.ws + WS_CNT);
    LAS float* wr = (LAS float*)F.lds;
    LAS int* sel = (LAS int*)(F.lds + 32768);
    { float rw[16];
#pragma unroll
      for (int j = 0; j < 16; ++j) rw[j] = a.in[I_WROUTER][F_tid + j * NTHR];
#pragma unroll
      for (int j = 0; j < 16; ++j) { const int i = F_tid + j * NTHR; const int kk = i >> 3, e = i & 7, g = (kk >> 8) * 4 + (kk & 3), lk = (kk >> 2) & 63; wr[((g * 2 + (e >> 2)) * 64 + lk) * 4 + (e & 3)] = rw[j]; } }
    for (int q = blockIdx.x; q < NLAT / 128; q += F.G) {
        __syncthreads();
        for (int i4 = 0; i4 < 4; ++i4) {
            const int tok0 = q * 128 + F.wave * 16 + 4 * i4, b = tok0 >> 11, tl0 = tok0 & 2047;
            const int r0 = b * TOT + NCTX + tl0;
            const float* m = MOD + b * 6144 + 3 * DM;
            const bf16* x0 = (const bf16*)(a.ws + WS_XL) + (size_t)tok0 * DM;
            const void* const xr[4] = {x0, x0 + DM, x0 + 2 * DM, x0 + 3 * DM};
            bf16* const orw[4] = {HB + (size_t)r0 * DM, HB + (size_t)(r0 + 1) * DM, HB + (size_t)(r0 + 2) * DM, HB + (size_t)(r0 + 3) * DM};
            f32x4 hv4[4][4];
            norm_mod_rows4<true>(xr, a.in[I_GN2] + DM, m, m + DM, orw, F_lane, hv4);
#pragma unroll
            for (int qq = 0; qq < 4; ++qq) {
            const int tok = tok0 + qq, i = 4 * i4 + qq;
            float lg[8];
#pragma unroll
            for (int e = 0; e < 8; ++e) lg[e] = 0.f;
#pragma unroll
            for (int j = 0; j < 4; ++j)
#pragma unroll
                for (int c = 0; c < 4; ++c) { const int g = j * 4 + c; const f32x4 w0 = *(const LAS f32x4*)(wr + ((g * 2) * 64 + F_lane) * 4), w1 = *(const LAS f32x4*)(wr + ((g * 2 + 1) * 64 + F_lane) * 4); const float hh = hv4[qq][j][c];
                    lg[0] += hh * w0.x; lg[1] += hh * w0.y; lg[2] += hh * w0.z; lg[3] += hh * w0.w; lg[4] += hh * w1.x; lg[5] += hh * w1.y; lg[6] += hh * w1.z; lg[7] += hh * w1.w; }
            {
                const bool b0 = F_lane & 1, b1 = F_lane & 2, b2 = F_lane & 4;
                float k4[4];
#pragma unroll
                for (int i2 = 0; i2 < 4; ++i2) { const float snd = b0 ? lg[i2] : lg[i2 + 4]; k4[i2] = (b0 ? lg[i2 + 4] : lg[i2]) + __shfl_xor(snd, 1); }
                float k2[2];
#pragma unroll
                for (int i2 = 0; i2 < 2; ++i2) { const float snd = b1 ? k4[i2] : k4[i2 + 2]; k2[i2] = (b1 ? k4[i2 + 2] : k4[i2]) + __shfl_xor(snd, 2); }
                float k1; { const float snd = b2 ? k2[0] : k2[1]; k1 = (b2 ? k2[1] : k2[0]) + __shfl_xor(snd, 4); }
                k1 += __shfl_xor(k1, 8); k1 += __shfl_xor(k1, 16); k1 += __shfl_xor(k1, 32);
                const int kb = __builtin_bit_cast(int, k1);
#pragma unroll
                for (int e = 0; e < 8; ++e) lg[e] = __builtin_bit_cast(float, __builtin_amdgcn_readlane(kb, (e >> 2) | (((e >> 1) & 1) << 1) | ((e & 1) << 2))); }
            int e0 = 0; float v0 = lg[0];
#pragma unroll
            for (int e = 1; e < 8; ++e) if (lg[e] > v0) { v0 = lg[e]; e0 = e; }
            int e1 = -1; float v1 = -3.0e38f;
#pragma unroll
            for (int e = 0; e < 8; ++e) if (e != e0 && lg[e] > v1) { v1 = lg[e]; e1 = e; }
            const float g0 = frcp(1.f + fexp2((v1 - v0) * LOG2E));
            if (F_lane == 0) { RE[tok * 2] = e0; RE[tok * 2 + 1] = e1; RG[tok * 2] = g0; RG[tok * 2 + 1] = 1.f - g0; sel[(F.wave * 16 + i) * 2] = e0; sel[(F.wave * 16 + i) * 2 + 1] = e1; }
            }
        }
        __syncthreads();
        if (F.wave == 0) {
            int c8[8];
#pragma unroll
            for (int e = 0; e < 8; ++e) c8[e] = 0;
#pragma unroll
            for (int p = 0; p < 4; ++p) { const int v = sel[p * 64 + F_lane];
#pragma unroll
                for (int e = 0; e < 8; ++e) c8[e] += __builtin_popcountll(__ballot(v == e)); }
            int mine = c8[0];
#pragma unroll
            for (int e = 1; e < 8; ++e) mine = (F_lane == e) ? c8[e] : mine;
            if (F_lane < 8) CNT[q * 8 + F_lane] = mine; }
    }
    __syncthreads();
}

__device__ __forceinline__ void slots_phase(const Frame& F, const Args& a) {
    const int F_lane = lane_id(), F_tid = F.wave * 64 + F_lane; (void)F_tid;
    const int* RE = (const int*)(a.ws + WS_RE); const int* CNT = (const int*)(a.ws + WS_CNT);
    int* SLOT = (int*)(a.ws + WS_SLOT); int* ROWIDX = (int*)(a.ws + WS_ROWIDX); int* TB = (int*)(a.ws + WS_TB);
    LAS int* cn = (LAS int*)F.lds;
    LAS int* ptot = cn + 2048;
    LAS int* ppre = ptot + 512;
    LAS int* tot = ppre + 512;
    LAS int* pre = tot + 8;
    LAS int* base = pre + 8;
    LAS int* sel = base + 16;
    for (int q = blockIdx.x; q < NLAT / 128; q += F.G) {
        __syncthreads();
        for (int i = F_tid; i < 2048; i += NTHR) cn[i] = CNT[i];
        if (F_tid < 256) sel[F_tid] = RE[q * 256 + F_tid];
        __syncthreads();
        { const int e = F_tid & 7, seg = F_tid >> 3; int t = 0, p = 0;
#pragma unroll
          for (int j = 0; j < 4; ++j) { const int w = seg * 4 + j, c = cn[w * 8 + e]; t += c; p += (w < q) ? c : 0; }
          ptot[seg * 8 + e] = t; ppre[seg * 8 + e] = p; }
        __syncthreads();
        if (F_tid < 8) { int t = 0, p = 0;
#pragma unroll 8
            for (int s = 0; s < 64; ++s) { t += ptot[s * 8 + F_tid]; p += ppre[s * 8 + F_tid]; }
            tot[F_tid] = t; pre[F_tid] = p; }
        __syncthreads();
        if (F_tid == 0) { int bs = 0; for (int e = 0; e < 8; ++e) { base[e] = bs; bs += (tot[e] + 255) & ~255; } base[8] = bs; }
        __syncthreads();
        if (F.wave == 0) {
            int st[8];
#pragma unroll
            for (int e = 0; e < 8; ++e) st[e] = base[e] + pre[e];
            const unsigned long long below = (1ull << F_lane) - 1ull;
#pragma unroll
            for (int p = 0; p < 4; ++p) { const int i = p * 64 + F_lane, v = sel[i]; int myslot = 0;
#pragma unroll
                for (int e = 0; e < 8; ++e) { const unsigned long long m = __ballot(v == e); myslot = (v == e) ? st[e] + __builtin_popcountll(m & below) : myslot; st[e] += __builtin_popcountll(m); }
                const int tok = q * 128 + (i >> 1); SLOT[q * 256 + i] = myslot; ROWIDX[myslot] = (tok >> 11) * TOT + NCTX + (tok & 2047); } }
        if (q == 0) {
            if (F_tid < 9) TB[F_tid] = base[F_tid] >> 8;
            for (int e = 0; e < 8; ++e) for (int s = base[e] + tot[e] + F_tid; s < base[e + 1]; s += NTHR) ROWIDX[s] = NCTX;
        }
    }
    __syncthreads();
}

__device__ __forceinline__ v2u tail_y(const GAS v2u* yrow_lane, const float* PART, int slot, int j, int lane) {
    constexpr int TAIL0 = (MOE_NCHUNK - 1) * MOE_CHUNK * 256;
    if (slot < TAIL0) return yrow_lane[64 * j];
    const GAS f32x4* p = (const GAS f32x4*)(PART + (size_t)(slot - TAIL0) * DM) + 64 * j + lane; const size_t st = (size_t)2048 * DM / 4;
    const f32x4 s = (p[0] + p[st]) + (p[2 * st] + p[3 * st]);
    v2u w; w.x = pk2(s.x, s.y); w.y = pk2(s.z, s.w); return w;
}
__device__ __forceinline__ void final_phase(const Frame& F, const Args& a) {
    const int F_lane = lane_id(), F_tid = F.wave * 64 + F_lane; (void)F_tid;
    const float* MOD = (const float*)(a.ws + WS_MOD) + (size_t)17 * 6144;
    const bf16* YA = (const bf16*)(a.ws + WS_YA); const bf16* YB = (const bf16*)(a.ws + WS_YB) - (size_t)32768 * DM; const float* PART = (const float*)(a.ws + WS_PART);
    const int* SLOT = (const int*)(a.ws + WS_SLOT); const float* RG = (const float*)(a.ws + WS_RG);
    const int gw = F.vcu * NWAVES + F.wave, NGW = F.G * NWAVES;
    for (int t2 = gw; t2 < NLAT / 2; t2 += NGW) {
        const int tok0 = 2 * t2, b = tok0 >> 11;
        const float* gt = MOD + b * 6144 + 5 * DM;
        const v4u sl = *(const GAS v4u*)(SLOT + tok0 * 2); const f32x4 rg = *(const GAS f32x4*)(RG + tok0 * 2);
        const int s0[2] = {(int)sl.x, (int)sl.z}, s1[2] = {(int)sl.y, (int)sl.w};
        const float g0[2] = {rg.x, rg.z}, g1[2] = {rg.y, rg.w};
        f32x4 x[2][4]; v2u ya[2][4], yb[2][4];
#pragma unroll
        for (int q = 0; q < 2; ++q) { const GAS v2u* xr = (const GAS v2u*)((const bf16*)(a.ws + WS_XL) + (size_t)(tok0 + q) * DM) + F_lane;
            const GAS v2u* y0 = (const GAS v2u*)((s0[q] < 32768 ? YA : YB) + (size_t)s0[q] * DM) + F_lane; const GAS v2u* y1 = (const GAS v2u*)((s1[q] < 32768 ? YA : YB) + (size_t)s1[q] * DM) + F_lane;
#pragma unroll
            for (int j = 0; j < 4; ++j) { const v2u w = xr[64 * j]; x[q][j] = (f32x4){bflo(w.x), bfhi(w.x), bflo(w.y), bfhi(w.y)}; ya[q][j] = tail_y(y0, PART, s0[q], j, F_lane); yb[q][j] = tail_y(y1, PART, s1[q], j, F_lane); } }
#pragma unroll
        for (int q = 0; q < 2; ++q) { float ss = 0.f;
#pragma unroll
            for (int j = 0; j < 4; ++j) { const v2u a0 = ya[q][j], a1 = yb[q][j]; const f32x4 gv = ((const GAS f32x4*)gt)[64 * j + F_lane];
                f32x4 mo; mo.x = g0[q] * bflo(a0.x) + g1[q] * bflo(a1.x); mo.y = g0[q] * bfhi(a0.x) + g1[q] * bfhi(a1.x); mo.z = g0[q] * bflo(a0.y) + g1[q] * bflo(a1.y); mo.w = g0[q] * bfhi(a0.y) + g1[q] * bfhi(a1.y);
                x[q][j] = x[q][j] + gv * mo; ss += (x[q][j].x * x[q][j].x + x[q][j].y * x[q][j].y) + (x[q][j].z * x[q][j].z + x[q][j].w * x[q][j].w); }
            const float rstd = 1.f / sqrtf(wave_sum(ss) * (1.f / DM) + EPS);
            GAS f32x4* xw = (GAS f32x4*)(a.out + (size_t)(tok0 + q) * DM) + F_lane;
#pragma unroll
            for (int j = 0; j < 4; ++j) { const f32x4 gf = ((const GAS f32x4*)a.in[I_GFINAL])[64 * j + F_lane]; xw[64 * j] = x[q][j] * rstd * gf; } }
    }
}

constexpr int NPHASE = 16 + 2 * MOE_NCHUNK;
__global__ void __launch_bounds__(NTHR, 2) fwd(Args args) {
    extern __shared__ __attribute__((aligned(16))) unsigned char lds[];
    Frame F;
    F.lds = (LAS unsigned char*)lds;
    F.wave = __builtin_amdgcn_readfirstlane((int)threadIdx.x >> 6);
    F.G = gridDim.x; { const int bx = blockIdx.x; F.vcu = (F.G % 8 == 0) ? (bx % 8) * (F.G / 8) + bx / 8 : bx; }
    unsigned char* ws = args.ws;
    for (int u = F.wave * 64 + lane_id(); u < (LDS_BYTES - LDSCTL_OFF) / 4; u += NTHR) ((LAS unsigned*)(F.lds + LDSCTL_OFF))[u] = 0u;
    __syncthreads();
#if MK_ONE_LAUNCH
    XcdBarrier bar = xcd_barrier_post((unsigned*)(ws + WS_CTL) + CW_BAR, (volatile LAS unsigned*)(F.lds + MISC_OFF) + 8);
#define GRID_BAR() xcd_barrier(bar)
#else
#define GRID_BAR() do {} while (0)
#endif
    const int lo = args.ph_lo, hi = args.ph_hi;
#define IN(k) (lo <= (k) && (k) < hi)
#define SEAM(k) do { if (IN(k) && IN((k) + 1)) GRID_BAR(); } while (0)
    const float* MOD0 = (const float*)(ws + WS_MOD); const float* MOD1 = MOD0 + 17 * 6144;
    pg8::bf16_t* const RA = (pg8::bf16_t*)args.out;
    pg8::bf16_t* const XL = (pg8::bf16_t*)(ws + WS_XL); pg8::bf16_t* const XC = (pg8::bf16_t*)(ws + WS_XC);

    if (IN(0)) { p0_prologue(F, args); SEAM(0); }
    if (IN(1)) { norm_phase<false>(F, args, 0, 0, args.in[I_X], args.in[I_CTX], args.in[I_GN1], nullptr); SEAM(1); }
    if (IN(2)) {
        pg8::Gemm g{RA, (const pg8::bf16_t*)(ws + WS_WINAB), DM, DM}; SchedAll S; S.D.init(MROWS / 256, ABP / 256, F.G, (int)blockIdx.x); S.rowbytes = DM * 2;
        EpiBf16 E{(pg8::bf16_t*)(ws + WS_PROJ0), ABP, 0, 1.f};
        pg8::gemm_phase<EpiBf16, SchedAll, true>(F.lds, F.wave, g, S, E); SEAM(2); }
    if (IN(3)) { qkprep_phase(F, args);
        if (F.G > 128) GRID_BAR();
        gla_mfma_phase(F, args);
        { const int first = F.G > 128 ? 128 : 0; moe_weights_convert(F, args, first, F.G - first); }
        if (F.G > 128) { __syncthreads(); attnA_side(F, args, (char*)lds); }
        SEAM(3); }
    if (IN(4)) { if (F.G > 128) attnA_phase(F, args, (char*)lds); else { for (int u = F.vcu; u < 1024 + 128; u += F.G) attnA_unit(F, args, (char*)lds, u); }
        gla_combine_phase(F, args); SEAM(4); }
    if (IN(5)) {
        pg8::Gemm g{RA, (const pg8::bf16_t*)(ws + WS_WOUTAB), DM, DM}; SchedAll S; S.D.init(MROWS / 256, DM / 256, F.G, (int)blockIdx.x); S.rowbytes = DM * 2;
        EpiResid<true> E{args.in[I_X], args.in[I_CTX], XL, XC, MOD0, 2};
        pg8::gemm_phase<EpiResid<true>, SchedAll, true>(F.lds, F.wave, g, S, E); SEAM(5); }
    if (IN(6)) { norm_phase<true>(F, args, 0, 1, XL, XC, args.in[I_GN2], nullptr); SEAM(6); }
    if (IN(7)) {
        pg8::Gemm g{RA, (const pg8::bf16_t*)(ws + WS_WFF1), DM, DM}; SchedAll S; S.D.init(MROWS / 256, 2 * DFF / 256, F.G, (int)blockIdx.x); S.rowbytes = DM * 2;
        EpiSwiglu E{(pg8::bf16_t*)(ws + WS_ACT), DFF};
        pg8::gemm_phase<EpiSwiglu, SchedAll, true>(F.lds, F.wave, g, S, E); SEAM(7); }
    if (IN(8)) {
        { pg8::Gemm g{(const pg8::bf16_t*)(ws + WS_ACT), (const pg8::bf16_t*)(ws + WS_WFF2), DFF, DFF}; SchedLat S; S.D.init(NLAT / 256, DM / 256, F.G, (int)blockIdx.x); S.rowbytes = DFF * 2;
          EpiResid<false> E{XL, XC, XL, XC, MOD0, 5};
          pg8::gemm_phase<EpiResid<false>, SchedLat, true>(F.lds, F.wave, g, S, E); }
        { pg8::Gemm g{(const pg8::bf16_t*)(ws + WS_ACT), (const pg8::bf16_t*)(ws + WS_WFF2), DFF / 4, DFF}; SchedCtxSplit S{F.G, (int)blockIdx.x, DFF / 4, DFF * 2};
          EpiCtxSplit E{XC, XC, MOD0 + 16 * 6144 + 5 * DM, (float*)(ws + WS_PARTC)};
          pg8::gemm_phase<EpiCtxSplit, SchedCtxSplit, true>(F.lds, F.wave, g, S, E); }
        SEAM(8); }
    if (IN(9)) { norm_phase<true>(F, args, 1, 0, XL, XC, args.in[I_GN1] + DM, MOD0 + 16 * 6144 + 5 * DM); SEAM(9); }
    if (IN(10)) {
        pg8::Gemm g{RA, (const pg8::bf16_t*)(ws + WS_WINC), DM, DM}; SchedAll S; S.D.init(MROWS / 256, QKVW / 256, F.G, (int)blockIdx.x); S.rowbytes = DM * 2;
        EpiBf16 E{(pg8::bf16_t*)(ws + WS_QKV), QKVW, 4, C2};
        pg8::gemm_phase<EpiBf16, SchedAll, true>(F.lds, F.wave, g, S, E); SEAM(10); }
    if (IN(11)) { na_phase(F, args, (char*)lds); SEAM(11); }
    if (IN(12)) {
        pg8::Gemm g{RA, (const pg8::bf16_t*)(ws + WS_WOUTC), DM, DM}; SchedLat S; S.D.init(NLAT / 256, DM / 256, F.G, (int)blockIdx.x); S.rowbytes = DM * 2;
        EpiResid<false> E{XL, XC, XL, XC, MOD1, 2};
        pg8::gemm_phase<EpiResid<false>, SchedLat, true>(F.lds, F.wave, g, S, E); SEAM(12); }
    if (IN(13)) { router_phase(F, args); SEAM(13); }
    if (IN(14)) { slots_phase(F, args); SEAM(14); }
    for (int st = 0; st < MOE_NCHUNK; ++st) {
        const int c = st == 0 ? MOE_NCHUNK - 1 : st - 1;
        const int* TB = (const int*)(ws + WS_TB);
        if (IN(15 + 2 * st)) {
            SchedMoe1 S; const int T = TB[8]; const int m0 = c * MOE_CHUNK; int nMc = T - m0; nMc = nMc < 0 ? 0 : (nMc > MOE_CHUNK ? MOE_CHUNK : nMc);
#pragma unroll
            for (int k = 0; k < 8; ++k) S.tb[k] = TB[k];
            S.m0 = m0; S.rowidx = (const int*)(ws + WS_ROWIDX); S.D.init(nMc, 2 * DFF / 256, F.G, (int)blockIdx.x);
            pg8::Gemm g{RA, (const pg8::bf16_t*)(ws + WS_WMOE1), DM, DM};
            EpiSwiglu E{(pg8::bf16_t*)(ws + WS_ACTC), DFF};
            pg8::gemm_phase<EpiSwiglu, SchedMoe1, true>(F.lds, F.wave, g, S, E); SEAM(15 + 2 * st); }
        if (IN(16 + 2 * st)) {
            SchedMoe2 S; const int T = TB[8]; const int m0 = c * MOE_CHUNK; int nMc = T - m0; nMc = nMc < 0 ? 0 : (nMc > MOE_CHUNK ? MOE_CHUNK : nMc);
#pragma unroll
            for (int k = 0; k < 8; ++k) S.tb[k] = TB[k];
            if (c < MOE_NCHUNK - 1) {
                S.m0 = m0; S.D.init(nMc, DM / 256, F.G, (int)blockIdx.x);
                pg8::Gemm g{(const pg8::bf16_t*)(ws + WS_ACTC), (const pg8::bf16_t*)(ws + WS_WMOE2), DFF, DFF};
                EpiBf16 E{c == 0 ? (pg8::bf16_t*)(ws + WS_YA) : (pg8::bf16_t*)(ws + WS_YB) - (size_t)32768 * DM, DM, 0, 1.f};
                pg8::gemm_phase<EpiBf16, SchedMoe2, true>(F.lds, F.wave, g, S, E);
            } else {
                SchedMoe2Split SS; SS.G = F.G; SS.c = (int)blockIdx.x; SS.nT = nMc; SS.m0 = m0;
#pragma unroll
                for (int k = 0; k < 8; ++k) SS.tb[k] = S.tb[k];
                pg8::Gemm g{(const pg8::bf16_t*)(ws + WS_ACTC), (const pg8::bf16_t*)(ws + WS_WMOE2), DFF / 4, DFF};
                EpiPartF32 E{(float*)(ws + WS_PART)};
                pg8::gemm_phase<EpiPartF32, SchedMoe2Split, true>(F.lds, F.wave, g, SS, E);
            }
            SEAM(16 + 2 * st); }
    }
    if (IN(NPHASE - 1)) { final_phase(F, args); }
#undef IN
#undef SEAM
}

extern "C" void kernel_launch(void* const* d_in, const int* in_sizes, int n_in, void* d_out, int out_size, void* d_ws, size_t ws_size, hipStream_t stream) {
    static int grid = 0;
    if (grid == 0) {
        if (n_in != 28 || out_size != NLAT * DM || ws_size < WS_END) { fprintf(stderr, "kernel_launch: unexpected problem (n_in %d, out %d, ws %zu < %zu)\n", n_in, out_size, ws_size, (size_t)WS_END); grid = -1; return; }
        int dev = 0, cus = 0, per_cu = 0;
        if (hipGetDevice(&dev) != hipSuccess || hipDeviceGetAttribute(&cus, hipDeviceAttributeMultiprocessorCount, dev) != hipSuccess) { grid = -1; return; }
        if (hipFuncSetAttribute((const void*)fwd, hipFuncAttributeMaxDynamicSharedMemorySize, LDS_BYTES) != hipSuccess) { fprintf(stderr, "kernel_launch: hipFuncSetAttribute failed\n"); grid = -1; return; }
        if (hipOccupancyMaxActiveBlocksPerMultiprocessor(&per_cu, (const void*)fwd, NTHR, LDS_BYTES) != hipSuccess || per_cu < 1) fprintf(stderr, "kernel_launch: occupancy query reports %d\n", per_cu);
        (void)hipGetLastError();
        grid = cus;
    }
    if (grid < 0) return;
    (void)hipMemsetAsync((char*)d_ws + WS_CTL, 0, CTL_ZERO_BYTES, stream);
    Args a{};
    for (int i = 0; i < 28; ++i) a.in[i] = (const float*)d_in[i];
    a.out = (float*)d_out; a.ws = (unsigned char*)d_ws;
#if MK_ONE_LAUNCH
    a.ph_lo = 0; a.ph_hi = NPHASE;
    hipLaunchKernelGGL(fwd, dim3(grid), dim3(NTHR), LDS_BYTES, stream, a);
#else
    for (int p = 0; p < NPHASE; ++p) { a.ph_lo = p; a.ph_hi = p + 1; hipLaunchKernelGGL(fwd, dim3(grid), dim3(NTHR), LDS_BYTES, stream, a); }
#endif
}
```
